# Optimizing an MI355X kernel written in HIP

```python
import math
import jax
import jax.numpy as jnp
from jax import lax
import numpy as np

D_MODEL = 1024
BATCH = 2
SEQ = 8192
DEPTH = 4

GRID_W = 64
CTX_LEN = 256
ROPE_THETA = 10000.0
NORM_EPS = 1e-6
Q_BLOCK = 128

A_HEADS = 4
A_HD = 64
A_VD = 2 * A_HD
A_SCALE = A_HD ** -0.5
A_PROJ = 4 * A_HEADS * A_HD + A_HEADS * A_VD

B_HEADS = 4
B_NOPE = 128
B_ROPE = 64
B_VD = 128
B_Q_RANK = 256
B_KV_RANK = 128
B_SCALE = (B_NOPE + B_ROPE) ** -0.5
B_PROJ = B_Q_RANK + B_KV_RANK + B_ROPE

AB_PROJ = A_PROJ + B_PROJ
AB_OUT = A_HEADS * A_VD + B_HEADS * B_VD

C_HEADS = 8
C_HD = D_MODEL // C_HEADS
C_WIDTH = C_HEADS * C_HD
C_PROJ = 5 * C_WIDTH
C_CHUNK = 64

N_EXPERTS = 32
TOP_K = 4
D_FF = D_MODEL
SWIGLU_ALPHA = 1.702
SWIGLU_LIMIT = 7.0
MOE_BLOCK = 128

N_AB_LAYERS = (DEPTH + 1) // 2
N_C_LAYERS = DEPTH // 2

kernel_name = 'hybrid_diff_mla_hgrn2_moe'


def rms_norm(x, g):
    xf = x.astype(jnp.float32)
    y = xf * lax.rsqrt(jnp.mean(xf * xf, axis=-1, keepdims=True) + NORM_EPS)
    return (y * g.astype(jnp.float32)).astype(x.dtype)


def axial_rope_tables(rows, rot_dim):
    quarter = rot_dim // 4
    inv_freq = ROPE_THETA ** (-jnp.arange(quarter, dtype=jnp.float32) / quarter)
    t = jnp.arange(rows * GRID_W)
    row = (t // GRID_W).astype(jnp.float32)
    col = (t % GRID_W).astype(jnp.float32)
    ang_r = row[:, None] * inv_freq
    ang_c = col[:, None] * inv_freq
    return (jnp.cos(ang_r), jnp.sin(ang_r), jnp.cos(ang_c), jnp.sin(ang_c))


def _rotate(x, cos, sin):
    x1, x2 = jnp.split(x, 2, axis=-1)
    return jnp.concatenate([x1 * cos - x2 * sin, x2 * cos + x1 * sin], axis=-1)


def apply_axial_rope(x, tables):
    cr, sr, cc, sc = tables
    xr, xc = jnp.split(x, 2, axis=-1)
    return jnp.concatenate([_rotate(xr, cr, sr), _rotate(xc, cc, sc)], axis=-1).astype(x.dtype)


def merge_heads(o):
    b, h, t, d = o.shape
    return o.transpose(0, 2, 1, 3).reshape(b, t, h * d)


def context_attention(q, k, v, scale):
    s = jnp.einsum('bhqd,bhkd->bhqk', q, k, preferred_element_type=jnp.float32) * scale
    p = jax.nn.softmax(s, axis=-1)
    return jnp.einsum('bhqk,bhkd->bhqd', p.astype(v.dtype), v)


def latent_attention(q, k_lat, v_lat, k_ctx, v_ctx, scale):
    k = jnp.concatenate([k_ctx, k_lat], axis=2)
    v = jnp.concatenate([v_ctx, v_lat], axis=2)
    b, h, n, dk = q.shape
    nb = n // Q_BLOCK
    qb = jnp.moveaxis(q.reshape(b, h, nb, Q_BLOCK, dk), 2, 0)
    ob = lax.map(lambda qi: context_attention(qi, k, v, scale), qb)
    return jnp.moveaxis(ob, 0, 2).reshape(b, h, n, v.shape[-1])


def diff_heads(p, rope):
    b, t, _ = p.shape
    q, k, v = jnp.split(p, [2 * A_HEADS * A_HD, 4 * A_HEADS * A_HD], axis=-1)
    q = q.reshape(b, t, 2 * A_HEADS, A_HD).transpose(0, 2, 1, 3)
    k = k.reshape(b, t, 2 * A_HEADS, A_HD).transpose(0, 2, 1, 3)
    v = v.reshape(b, t, A_HEADS, A_VD).transpose(0, 2, 1, 3)
    v = jnp.repeat(v, 2, axis=1)
    if rope is not None:
        q = apply_axial_rope(q, rope)
        k = apply_axial_rope(k, rope)
    return q, k, v


def diff_combine(o2, lam, lam_init, subln_g):
    b, _, t, vd = o2.shape
    o2 = o2.reshape(b, A_HEADS, 2, t, vd)
    o = o2[:, :, 0] - lam * o2[:, :, 1]
    o = rms_norm(o, subln_g) * (1.0 - lam_init)
    return merge_heads(o)


def mla_heads(p, q_norm_g, kv_norm_g, w_uq, w_ukv, rope):
    b, t, _ = p.shape
    c_q, c_kv, k_r = jnp.split(p, [B_Q_RANK, B_Q_RANK + B_KV_RANK], axis=-1)
    q = (rms_norm(c_q, q_norm_g) @ w_uq).reshape(b, t, B_HEADS, B_NOPE + B_ROPE).transpose(0, 2, 1, 3)
    kv = (rms_norm(c_kv, kv_norm_g) @ w_ukv).reshape(b, t, B_HEADS, B_NOPE + B_VD).transpose(0, 2, 1, 3)
    q_nope, q_r = jnp.split(q, [B_NOPE], axis=-1)
    k_nope, v = jnp.split(kv, [B_NOPE], axis=-1)
    k_r = k_r[:, None]
    if rope is not None:
        q_r = apply_axial_rope(q_r, rope)
        k_r = apply_axial_rope(k_r, rope)
    q = jnp.concatenate([q_nope, q_r], axis=-1)
    k = jnp.concatenate([k_nope, jnp.broadcast_to(k_r, (b, B_HEADS, t, B_ROPE))], axis=-1)
    return q, k, v


def ab_mixer(u_lat, u_ctx, w_in, diff_lambda, subln_g, q_norm_g, kv_norm_g, w_uq, w_ukv, w_out,
             lam_init, rope_a, rope_b, with_ctx_out):
    p_lat = u_lat @ w_in
    p_ctx = u_ctx @ w_in
    lf = diff_lambda.astype(jnp.float32)
    lam = jnp.exp(jnp.sum(lf[0] * lf[1])) - jnp.exp(jnp.sum(lf[2] * lf[3])) + lam_init
    qa, ka, va = diff_heads(p_lat[..., :A_PROJ], rope_a)
    qac, kac, vac = diff_heads(p_ctx[..., :A_PROJ], None)
    qb, kb, vb = mla_heads(p_lat[..., A_PROJ:], q_norm_g, kv_norm_g, w_uq, w_ukv, rope_b)
    qbc, kbc, vbc = mla_heads(p_ctx[..., A_PROJ:], q_norm_g, kv_norm_g, w_uq, w_ukv, None)
    oa = diff_combine(latent_attention(qa, ka, va, kac, vac, A_SCALE), lam, lam_init, subln_g)
    ob = merge_heads(latent_attention(qb, kb, vb, kbc, vbc, B_SCALE))
    y_lat = jnp.concatenate([oa, ob], axis=-1).astype(u_lat.dtype) @ w_out
    y_ctx = None
    if with_ctx_out:
        oac = diff_combine(context_attention(qac, kac, vac, A_SCALE), lam, lam_init, subln_g)
        obc = merge_heads(context_attention(qbc, kbc, vbc, B_SCALE))
        y_ctx = jnp.concatenate([oac, obc], axis=-1).astype(u_ctx.dtype) @ w_out
    return y_lat, y_ctx


def gla_chunk_scan(q, k, v, log_f, s0):
    b, h, t, dk = q.shape
    dv = v.shape[-1]
    n = t // C_CHUNK

    def to_chunks(a):
        return jnp.moveaxis(a.reshape(b, h, n, C_CHUNK, a.shape[-1]), 2, 0)

    mask = jnp.tril(jnp.ones((C_CHUNK, C_CHUNK), dtype=bool))[:, :, None]

    def step(s, inp):
        qc, kc, vc, lf = inp
        cum = jnp.cumsum(lf, axis=2)
        rel = jnp.where(mask, cum[:, :, :, None, :] - cum[:, :, None, :, :], -jnp.inf)
        att = jnp.einsum('bhtd,bhsd,bhtsd->bhts', qc, kc, jnp.exp(rel))
        o = jnp.einsum('bhts,bhse->bhte', att, vc) + jnp.einsum('bhtd,bhde->bhte', qc * jnp.exp(cum), s)
        last = cum[:, :, -1]
        s_new = jnp.exp(last)[..., None] * s + jnp.einsum(
            'bhsd,bhse->bhde', kc * jnp.exp(last[:, :, None, :] - cum), vc)
        return s_new, o

    s_fin, o = lax.scan(step, s0, (to_chunks(q), to_chunks(k), to_chunks(v), to_chunks(log_f)))
    return jnp.moveaxis(o, 0, 2).reshape(b, h, t, dv), s_fin


def hgrn2_mixer(u_lat, u_ctx, w_in, lb, norm_g, w_out, with_ctx_out):
    lbh = lb.astype(jnp.float32).reshape(C_HEADS, 1, C_HD)

    def project(u):
        b, t, _ = u.shape
        q, zf, zb, i, g = jnp.split(u @ w_in, 5, axis=-1)

        def heads(a):
            return a.reshape(b, t, C_HEADS, C_HD).transpose(0, 2, 1, 3)

        def gate(z):
            f = lbh + (1.0 - lbh) * jax.nn.sigmoid(heads(z).astype(jnp.float32))
            return 1.0 - f, jnp.log(f)

        return heads(q), heads(i), gate(zf), gate(zb), g

    def readout(o, g):
        b, _, t, _ = o.shape
        o = rms_norm(o, norm_g).transpose(0, 2, 1, 3).reshape(b, t, C_WIDTH)
        return (o * jax.nn.silu(g.astype(jnp.float32))).astype(g.dtype) @ w_out

    def flip(a):
        return jnp.flip(a, axis=2)

    q_c, v_c, (kf_c, lf_c), (kb_c, lgb_c), g_c = project(u_ctx)
    s0 = jnp.zeros((u_ctx.shape[0], C_HEADS, C_HD, C_HD), jnp.float32)
    o_cf, s_f = gla_chunk_scan(q_c, kf_c, v_c, lf_c, s0)
    o_cb, s_b = gla_chunk_scan(flip(q_c), flip(kb_c), flip(v_c), flip(lgb_c), s0)
    q_l, v_l, (kf_l, lf_l), (kb_l, lgb_l), g_l = project(u_lat)
    o_lf, _ = gla_chunk_scan(q_l, kf_l, v_l, lf_l, s_f)
    o_lb, _ = gla_chunk_scan(flip(q_l), flip(kb_l), flip(v_l), flip(lgb_l), s_b)
    y_lat = readout(o_lf + flip(o_lb), g_l)
    y_ctx = readout(o_cf + flip(o_cb), g_c) if with_ctx_out else None
    return y_lat, y_ctx


def expert_ffn(xb, w1, b1, w2, b2):
    h = jnp.dot(xb, w1) + b1
    x_glu = jnp.minimum(h[:, 0::2], SWIGLU_LIMIT)
    x_lin = jnp.clip(h[:, 1::2], -SWIGLU_LIMIT, SWIGLU_LIMIT)
    y = x_glu * jax.nn.sigmoid(SWIGLU_ALPHA * x_glu) * (x_lin + 1.0)
    return jnp.dot(y, w2) + b2


def moe_ffn(tok, w_router, b_router, w1, b1, w2, b2):
    t, d = tok.shape
    logits = jnp.einsum('td,de->te', tok, w_router, preferred_element_type=jnp.float32) + b_router.astype(jnp.float32)
    top_val, top_idx = lax.top_k(logits, TOP_K)
    gates = jax.nn.softmax(top_val, axis=-1)
    n_assign = t * TOP_K
    flat_e = top_idx.reshape(-1).astype(jnp.int32)
    flat_tok = jnp.arange(n_assign, dtype=jnp.int32) // TOP_K
    flat_g = gates.reshape(-1)
    order = jnp.argsort(flat_e)
    e_sorted = flat_e[order]
    counts = jnp.bincount(flat_e, length=N_EXPERTS).astype(jnp.int32)
    group_start = jnp.cumsum(counts) - counts
    padded = (counts + MOE_BLOCK - 1) // MOE_BLOCK * MOE_BLOCK
    pad_end = jnp.cumsum(padded)
    pad_start = pad_end - padded
    dest = pad_start[e_sorted] + (jnp.arange(n_assign, dtype=jnp.int32) - group_start[e_sorted])
    n_blocks = -(-n_assign // MOE_BLOCK) + N_EXPERTS
    n_rows = n_blocks * MOE_BLOCK
    row_tok = jnp.full((n_rows,), t, jnp.int32).at[dest].set(flat_tok[order])
    row_gate = jnp.zeros((n_rows,), jnp.float32).at[dest].set(flat_g[order])
    block_start = jnp.arange(n_blocks, dtype=jnp.int32) * MOE_BLOCK
    block_expert = jnp.minimum(jnp.searchsorted(pad_end, block_start, side='right'), N_EXPERTS - 1)
    tok_pad = jnp.concatenate([tok, jnp.zeros((1, d), tok.dtype)], axis=0)
    xb = tok_pad[row_tok].reshape(n_blocks, MOE_BLOCK, d)
    yb = lax.map(lambda a: expert_ffn(a[0], w1[a[1]], b1[a[1]], w2[a[1]], b2[a[1]]), (xb, block_expert))
    y = yb.reshape(n_rows, d) * row_gate[:, None].astype(yb.dtype)
    return jnp.zeros((t + 1, d), y.dtype).at[row_tok].add(y)[:t]


def setup_inputs(seed: int = 0) -> dict:
    key = jax.random.key(seed)
    keys = iter(jax.random.split(key, 40))

    def nrm(shape, scale):
        return jax.random.normal(next(keys), shape, jnp.float32) * scale

    def gain(shape):
        return 1.0 + nrm(shape, 0.05)

    D = D_MODEL
    return {
        'x': nrm((BATCH, SEQ, D), 1.0),
        'c': nrm((BATCH, D), 1.0),
        'ctx': nrm((BATCH, CTX_LEN, D), 1.0),
        'c_ctx': nrm((D,), 1.0),
        'norm_mix_g': gain((DEPTH, D)),
        'norm_ffn_g': gain((DEPTH, D)),
        'w_ada': nrm((DEPTH, D, 6 * D), 0.3 * D ** -0.5),
        'b_ada': nrm((DEPTH, 6 * D), 0.02),
        'w_in_ab': nrm((N_AB_LAYERS, D, AB_PROJ), D ** -0.5),
        'diff_lambda': nrm((N_AB_LAYERS, 4, A_HD), 0.1),
        'diff_subln_g': gain((N_AB_LAYERS, A_VD)),
        'mla_q_norm_g': gain((N_AB_LAYERS, B_Q_RANK)),
        'mla_kv_norm_g': gain((N_AB_LAYERS, B_KV_RANK)),
        'w_uq': nrm((N_AB_LAYERS, B_Q_RANK, B_HEADS * (B_NOPE + B_ROPE)), B_Q_RANK ** -0.5),
        'w_ukv': nrm((N_AB_LAYERS, B_KV_RANK, B_HEADS * (B_NOPE + B_VD)), B_KV_RANK ** -0.5),
        'w_out_ab': nrm((N_AB_LAYERS, AB_OUT, D), AB_OUT ** -0.5),
        'w_in_c': nrm((N_C_LAYERS, D, C_PROJ), D ** -0.5),
        'lb_raw': nrm((DEPTH, C_WIDTH), 0.1),
        'hgrn_norm_g': gain((N_C_LAYERS, C_HD)),
        'w_out_c': nrm((N_C_LAYERS, C_WIDTH, D), C_WIDTH ** -0.5),
        'w_router': nrm((DEPTH, D, N_EXPERTS), D ** -0.5),
        'b_router': nrm((DEPTH, N_EXPERTS), 0.01),
        'w_exp1': nrm((DEPTH, N_EXPERTS, D, 2 * D_FF), D ** -0.5),
        'b_exp1': nrm((DEPTH, N_EXPERTS, 2 * D_FF), 0.01),
        'w_exp2': nrm((DEPTH, N_EXPERTS, D_FF, D), D_FF ** -0.5),
        'b_exp2': nrm((DEPTH, N_EXPERTS, D), 0.01),
        'final_g': gain((D,)),
    }


def reference(x, c, ctx, c_ctx, norm_mix_g, norm_ffn_g, w_ada, b_ada, w_in_ab, diff_lambda, diff_subln_g,
              mla_q_norm_g, mla_kv_norm_g, w_uq, w_ukv, w_out_ab, w_in_c, lb_raw, hgrn_norm_g, w_out_c,
              w_router, b_router, w_exp1, b_exp1, w_exp2, b_exp2, final_g):
    b, n, d = x.shape
    rows = n // GRID_W
    rope_a = axial_rope_tables(rows, A_HD)
    rope_b = axial_rope_tables(rows, B_ROPE)
    lb_p = jax.nn.softmax(lb_raw.astype(jnp.float32), axis=0)
    lower_bounds = jnp.cumsum(lb_p, axis=0) - lb_p[0]
    silu_c = jax.nn.silu(c)
    silu_cc = jax.nn.silu(c_ctx)
    h, hc = x, ctx
    for l in range(DEPTH):
        last = l == DEPTH - 1
        sh1, sc1, g1, sh2, sc2, g2 = jnp.split((silu_c @ w_ada[l] + b_ada[l])[:, None, :], 6, axis=-1)
        csh1, csc1, cg1, csh2, csc2, cg2 = jnp.split(silu_cc @ w_ada[l] + b_ada[l], 6, axis=-1)
        u = rms_norm(h, norm_mix_g[l]) * (1.0 + sc1) + sh1
        uc = rms_norm(hc, norm_mix_g[l]) * (1.0 + csc1) + csh1
        j = l // 2
        if l % 2 == 0:
            lam_init = 0.8 - 0.6 * math.exp(-0.3 * l)
            y, yc = ab_mixer(u, uc, w_in_ab[j], diff_lambda[j], diff_subln_g[j], mla_q_norm_g[j],
                             mla_kv_norm_g[j], w_uq[j], w_ukv[j], w_out_ab[j], lam_init, rope_a, rope_b,
                             not last)
        else:
            y, yc = hgrn2_mixer(u, uc, w_in_c[j], lower_bounds[l], hgrn_norm_g[j], w_out_c[j], not last)
        h = h + g1 * y
        v = rms_norm(h, norm_ffn_g[l]) * (1.0 + sc2) + sh2
        moe_w = (w_router[l], b_router[l], w_exp1[l], b_exp1[l], w_exp2[l], b_exp2[l])
        if last:
            h = h + g2 * moe_ffn(v.reshape(b * n, d), *moe_w).reshape(b, n, d)
        else:
            hc = hc + cg1 * yc
            vc = rms_norm(hc, norm_ffn_g[l]) * (1.0 + csc2) + csh2
            out = moe_ffn(jnp.concatenate([v.reshape(b * n, d), vc.reshape(-1, d)], axis=0), *moe_w)
            h = h + g2 * out[:b * n].reshape(b, n, d)
            hc = hc + cg2 * out[b * n:].reshape(hc.shape)
    return rms_norm(h, final_g)
```

```cpp
#include <hip/hip_runtime.h>
#include <cstdio>
#include <cstdint>
namespace cfg {
constexpr int D = 1024, BATCH = 2, SEQ = 8192, DEPTH = 4, GRIDW = 64, CTX = 256;
constexpr int TB = CTX + SEQ;
constexpr int R = BATCH * TB;
constexpr int ABP = 1984, CP = 5120, NE = 32;
constexpr float EPS = 1e-6f;
constexpr float A_SCALE = 0.125f;
constexpr float B_SCALE = 0.07216878364870322f;
enum { I_X = 0, I_C, I_CTX, I_CCTX, I_NMG, I_NFG, I_WADA, I_BADA, I_WINAB, I_DLAM, I_SUBLN, I_QNG, I_KVNG, I_WUQ, I_WUKV, I_WOUTAB, I_WINC, I_LBRAW, I_HNG, I_WOUTC,
       I_WR, I_BR, I_W1, I_B1, I_W2, I_B2, I_FING };
}
namespace orc {
using namespace cfg;

__device__ __forceinline__ float siluf(float x) { return x / (1.f + expf(-x)); }
__device__ __forceinline__ int row_mod(int r) { const int b = r / TB, t = r % TB; return t < CTX ? 2 : b; }

__global__ void k_ada(const float* c, const float* c_ctx, const float* w_ada, const float* b_ada, float* mod) {
    const int idx = blockIdx.x * 256 + threadIdx.x; if (idx >= DEPTH * 3 * 6 * D) return;
    const int col = idx % (6 * D), j = (idx / (6 * D)) % 3, l = idx / (18 * D);
    const float* v = j < 2 ? c + j * D : c_ctx; const float* w = w_ada + (size_t)l * D * 6 * D;
    float acc = 0.f; for (int k = 0; k < D; ++k) acc += siluf(v[k]) * w[(size_t)k * 6 * D + col];
    mod[idx] = acc + b_ada[l * 6 * D + col];
}
__global__ void k_init_h(const float* x, const float* ctx, float* H) {
    const size_t i = (size_t)blockIdx.x * 256 + threadIdx.x; if (i >= (size_t)R * D) return;
    const int r = (int)(i / D), col = (int)(i % D), b = r / TB, t = r % TB;
    H[i] = t < CTX ? ctx[((size_t)b * CTX + t) * D + col] : x[((size_t)b * SEQ + (t - CTX)) * D + col];
}
__global__ void k_norm_mod(const float* H, const float* g, const float* mod_l, int sh_off, int sc_off, float* U) {
    const int r = blockIdx.x, tid = threadIdx.x; __shared__ float red[256];
    const float* h = H + (size_t)r * D; float s = 0.f;
    for (int k = tid; k < D; k += 256) s += h[k] * h[k];
    red[tid] = s; __syncthreads();
    for (int o = 128; o > 0; o >>= 1) { if (tid < o) red[tid] += red[tid + o]; __syncthreads(); }
    const float rs = rsqrtf(red[0] / D + EPS); const float* m = mod_l + row_mod(r) * 6 * D;
    for (int k = tid; k < D; k += 256) U[(size_t)r * D + k] = h[k] * rs * g[k] * (1.f + m[sc_off + k]) + m[sh_off + k];
}
struct GArgs { const float* A; int lda; const int* aidx; const int* aoff; const int* cnt; int M; const float* B; int ldb; int N, K; size_t b_stride;
               float* C; int ldc; const int* coff; const float* bias; int bias_stride; int epi; const float* mod_l; int gate_off; const float* rgate; const int* list; };
__global__ void __launch_bounds__(256) k_gemm(GArgs a) {
    __shared__ __attribute__((aligned(16))) float As[16][68], Bs[16][68];
    const int z = blockIdx.z, M = a.cnt ? a.cnt[z] : a.M, m0 = blockIdx.y * 64, n0 = blockIdx.x * 64; if (m0 >= M) return;
    const float* B = a.B + (size_t)z * a.b_stride; const float* bias = a.bias ? a.bias + (size_t)z * a.bias_stride : nullptr;
    const int abase = a.aoff ? a.aoff[z] : 0, cbase = a.coff ? a.coff[z] : 0;
    const int tid = threadIdx.x, tx = tid % 16, ty = tid / 16; float acc[4][4] = {};
    for (int k0 = 0; k0 < a.K; k0 += 16) {
        for (int i = tid; i < 64 * 16; i += 256) { const int mm = i / 16, kk = i % 16, gm = m0 + mm; float v = 0.f;
            if (gm < M) { const int ar = a.aidx ? a.aidx[(size_t)z * R + gm] : abase + gm; v = a.A[(size_t)ar * a.lda + k0 + kk]; } As[kk][mm] = v; }
        for (int i = tid; i < 16 * 64; i += 256) { const int kk = i / 64, nn = i % 64, gn = n0 + nn; Bs[kk][nn] = gn < a.N ? B[(size_t)(k0 + kk) * a.ldb + gn] : 0.f; }
        __syncthreads();
#pragma unroll
        for (int kk = 0; kk < 16; ++kk) { const float4 a4 = *(const float4*)&As[kk][ty * 4], b4 = *(const float4*)&Bs[kk][tx * 4];
            const float av[4] = {a4.x, a4.y, a4.z, a4.w}, bv[4] = {b4.x, b4.y, b4.z, b4.w};
#pragma unroll
            for (int i = 0; i < 4; ++i)
#pragma unroll
                for (int j = 0; j < 4; ++j) acc[i][j] += av[i] * bv[j]; }
        __syncthreads();
    }
    for (int i = 0; i < 4; ++i) { const int gm = m0 + ty * 4 + i; if (gm >= M) continue;
        for (int j = 0; j < 4; ++j) { const int gn = n0 + tx * 4 + j; if (gn >= a.N) continue; const float v = acc[i][j];
            if (a.epi == 0) { a.C[(size_t)(cbase + gm) * a.ldc + gn] = v + (bias ? bias[gn] : 0.f); }
            else if (a.epi == 1) { a.C[(size_t)gm * a.ldc + gn] += a.mod_l[row_mod(gm) * 6 * D + a.gate_off + gn] * v; }
            else { const int row = a.list[(size_t)z * R + gm]; atomicAdd(&a.C[(size_t)row * a.ldc + gn], a.mod_l[row_mod(row) * 6 * D + a.gate_off + gn] * a.rgate[(size_t)z * R + gm] * (v + bias[gn])); } } }
}
__global__ void k_rope(float* buf, int ld, int col_off, int nh, int hstride) {
    const int i = blockIdx.x * 256 + threadIdx.x; if (i >= R * nh * 32) return;
    const int p = i % 32, h = (i / 32) % nh, r = i / (32 * nh), t = r % TB; if (t < CTX) return;
    const int n = t - CTX, fi = p % 16, half = p / 16;
    const float inv = powf(10000.f, -(float)fi / 16.f), pos = half ? (float)(n % GRIDW) : (float)(n / GRIDW), ang = pos * inv;
    float sn, cs; sincosf(ang, &sn, &cs);
    float* x = buf + (size_t)r * ld + col_off + h * hstride + half * 32; const float x1 = x[fi], x2 = x[fi + 16];
    x[fi] = x1 * cs - x2 * sn; x[fi + 16] = x2 * cs + x1 * sn;
}
__global__ void k_rmsnorm_cols(const float* src, int ld, int col_off, int w, const float* g, float* dst) {
    const int r = blockIdx.x, tid = threadIdx.x; __shared__ float red[64]; const float* s = src + (size_t)r * ld + col_off; float q = 0.f;
    for (int k = tid; k < w; k += 64) q += s[k] * s[k];
    red[tid] = q; __syncthreads(); for (int o = 32; o > 0; o >>= 1) { if (tid < o) red[tid] += red[tid + o]; __syncthreads(); }
    const float rs = rsqrtf(red[0] / w + EPS); for (int k = tid; k < w; k += 64) dst[(size_t)r * w + k] = s[k] * rs * g[k];
}
__global__ void k_build_kb(const float* KVB, const float* P, float* KB) {
    const size_t i = (size_t)blockIdx.x * 256 + threadIdx.x; if (i >= (size_t)R * 768) return;
    const int r = (int)(i / 768), c = (int)(i % 768), h = c / 192, d = c % 192;
    KB[i] = d < 128 ? KVB[(size_t)r * 1024 + h * 256 + d] : P[(size_t)r * ABP + 1920 + (d - 128)];
}
struct AArgs { const float* Q; int ldq, qoff, qhs; const float* K; int ldk, koff, khs; const float* V; int ldv, voff, vhs, vdiv; float* O; int ldo, ooff, ohs; int dqk; float scale; int nheads; };
__global__ void __launch_bounds__(256) k_attn(AArgs a) {
    __shared__ float Qs[16][193], Ks[32][193], Vs[32][128], Ps[16][33];
    const int tid = threadIdx.x, qi = tid / 16, sub = tid % 16, dqk = a.dqk;
    const int blk = blockIdx.x, h = blockIdx.y, b = blockIdx.z, t0 = blk * 16; const int nkeys = t0 < CTX ? CTX : TB;
    const size_t rb = (size_t)b * TB;
    for (int i = tid; i < 16 * dqk; i += 256) { const int q = i / dqk, d = i % dqk; Qs[q][d] = a.Q[(rb + t0 + q) * a.ldq + a.qoff + h * a.qhs + d]; }
    float m = -1e30f, l = 0.f, o[8] = {};
    for (int k0 = 0; k0 < nkeys; k0 += 32) {
        __syncthreads();
        for (int i = tid; i < 32 * dqk; i += 256) { const int kk = i / dqk, d = i % dqk; Ks[kk][d] = a.K[(rb + k0 + kk) * a.ldk + a.koff + h * a.khs + d]; }
        for (int i = tid; i < 32 * 128; i += 256) { const int kk = i / 128, e = i % 128; Vs[kk][e] = a.V[(rb + k0 + kk) * a.ldv + a.voff + (h / a.vdiv) * a.vhs + e]; }
        __syncthreads();
        float s0 = 0.f, s1 = 0.f; for (int d = 0; d < dqk; ++d) { const float q = Qs[qi][d]; s0 += q * Ks[sub][d]; s1 += q * Ks[sub + 16][d]; }
        s0 *= a.scale; s1 *= a.scale; float mx = fmaxf(s0, s1);
        for (int o2 = 1; o2 < 16; o2 <<= 1) mx = fmaxf(mx, __shfl_xor(mx, o2));
        const float mn = fmaxf(m, mx), alpha = expf(m - mn), p0 = expf(s0 - mn), p1 = expf(s1 - mn); float ps = p0 + p1;
        for (int o2 = 1; o2 < 16; o2 <<= 1) ps += __shfl_xor(ps, o2);
        l = l * alpha + ps; m = mn; Ps[qi][sub] = p0; Ps[qi][sub + 16] = p1;
        __syncthreads();
        for (int j = 0; j < 8; ++j) o[j] *= alpha;
        for (int kk = 0; kk < 32; ++kk) { const float p = Ps[qi][kk]; for (int j = 0; j < 8; ++j) o[j] += p * Vs[kk][sub * 8 + j]; }
    }
    for (int j = 0; j < 8; ++j) a.O[(rb + t0 + qi) * a.ldo + a.ooff + h * a.ohs + sub * 8 + j] = o[j] / l;
}
__global__ void k_diff_combine(const float* OA2, const float* dl, const float* g, float lam_init, float* OCAT) {
    const int r = blockIdx.x, h = blockIdx.y, e = threadIdx.x; __shared__ float red[128]; __shared__ float lam_s;
    if (e == 0) { float s1 = 0.f, s2 = 0.f; for (int i = 0; i < 64; ++i) { s1 += dl[i] * dl[64 + i]; s2 += dl[128 + i] * dl[192 + i]; } lam_s = expf(s1) - expf(s2) + lam_init; }
    __syncthreads();
    const float v = OA2[(size_t)r * 1024 + (2 * h) * 128 + e] - lam_s * OA2[(size_t)r * 1024 + (2 * h + 1) * 128 + e];
    red[e] = v * v; __syncthreads(); for (int o = 64; o > 0; o >>= 1) { if (e < o) red[e] += red[e + o]; __syncthreads(); }
    OCAT[(size_t)r * 1024 + h * 128 + e] = v * rsqrtf(red[0] / 128.f + EPS) * g[e] * (1.f - lam_init);
}
__global__ void k_lb(const float* lb_raw, int l, float* lbl) {
    const int c = blockIdx.x * 256 + threadIdx.x; if (c >= D) return;
    float mx = -1e30f; for (int i = 0; i < DEPTH; ++i) mx = fmaxf(mx, lb_raw[i * D + c]);
    float e[DEPTH], s = 0.f; for (int i = 0; i < DEPTH; ++i) { e[i] = expf(lb_raw[i * D + c] - mx); s += e[i]; }
    float acc = 0.f; for (int i = 1; i <= l; ++i) acc += e[i] / s; lbl[c] = acc;
}
__global__ void __launch_bounds__(128) k_scan(const float* P, const float* lbl, float* Of, float* Ob) {
    const int h = blockIdx.x, dir = blockIdx.y, b = blockIdx.z, e = threadIdx.x; __shared__ float qs[128], ks[128], fs[128];
    float S[128];
#pragma unroll
    for (int d = 0; d < 128; ++d) S[d] = 0.f;
    const float lb = lbl[h * 128 + e]; float* O = dir ? Ob : Of;
    for (int step = 0; step < TB; ++step) {
        int t; if (dir == 0) t = step; else t = step < CTX ? CTX - 1 - step : TB - 1 - (step - CTX);
        const float* p = P + ((size_t)b * TB + t) * CP;
        __syncthreads();
        { const float z = p[(dir ? 2048 : 1024) + h * 128 + e]; const float f = lb + (1.f - lb) / (1.f + expf(-z)); fs[e] = f; ks[e] = 1.f - f; qs[e] = p[h * 128 + e]; }
        __syncthreads();
        const float v = p[3072 + h * 128 + e]; float o = 0.f;
#pragma unroll
        for (int d = 0; d < 128; ++d) { S[d] = fs[d] * S[d] + ks[d] * v; o += qs[d] * S[d]; }
        O[((size_t)b * TB + t) * D + h * 128 + e] = o;
    }
}
__global__ void k_readout(const float* Of, const float* Ob, const float* P, const float* g, float* RO) {
    const int r = blockIdx.x, h = blockIdx.y, e = threadIdx.x; __shared__ float red[128];
    const size_t i = (size_t)r * D + h * 128 + e; const float v = Of[i] + Ob[i];
    red[e] = v * v; __syncthreads(); for (int o = 64; o > 0; o >>= 1) { if (e < o) red[e] += red[e + o]; __syncthreads(); }
    RO[i] = v * rsqrtf(red[0] / 128.f + EPS) * g[e] * siluf(P[(size_t)r * CP + 4096 + h * 128 + e]);
}
__global__ void k_router(const float* V, const float* wr, const float* br, int nrows_limit_lat_only, int* cnt, int* list, float* lgate) {
    const int r = blockIdx.x, tid = threadIdx.x; if (nrows_limit_lat_only && (r % TB) < CTX) return;
    __shared__ float part[64]; __shared__ float lg[32];
    const int e = tid % 32, half = tid / 32; float acc = 0.f; const float* v = V + (size_t)r * D;
    for (int k = half * 512; k < half * 512 + 512; ++k) acc += v[k] * wr[k * NE + e];
    part[tid] = acc; __syncthreads(); if (tid < 32) lg[tid] = part[tid] + part[tid + 32] + br[tid]; __syncthreads();
    if (tid == 0) { int sel[4]; float val[4];
        for (int k = 0; k < 4; ++k) { int bi = -1; float bv = -1e30f; for (int i = 0; i < 32; ++i) { bool used = false; for (int j = 0; j < k; ++j) used |= sel[j] == i; if (!used && lg[i] > bv) { bv = lg[i]; bi = i; } } sel[k] = bi; val[k] = bv; }
        float s = 0.f, p[4]; for (int k = 0; k < 4; ++k) { p[k] = expf(val[k] - val[0]); s += p[k]; }
        for (int k = 0; k < 4; ++k) { const int pos = atomicAdd(&cnt[sel[k]], 1); list[(size_t)sel[k] * R + pos] = r; lgate[(size_t)sel[k] * R + pos] = p[k] / s; } }
}
__global__ void k_prefix(const int* cnt, int* off) { if (threadIdx.x == 0) { int s = 0; for (int e = 0; e < NE; ++e) { off[e] = s; s += cnt[e]; } } }
__global__ void k_swiglu(const float* H1, const int* cnt, const int* off, float* ACT) {
    const int z = blockIdx.z, row = blockIdx.y, c = blockIdx.x * 256 + threadIdx.x; if (row >= cnt[z]) return;
    const float* h = H1 + (size_t)(off[z] + row) * 2048; const float xg = fminf(h[2 * c], 7.f), xl = fminf(fmaxf(h[2 * c + 1], -7.f), 7.f);
    ACT[(size_t)(off[z] + row) * 1024 + c] = xg / (1.f + expf(-1.702f * xg)) * (xl + 1.f);
}
__global__ void k_final(const float* H, const float* g, float* out) {
    const int i = blockIdx.x, b = i / SEQ, n = i % SEQ, tid = threadIdx.x; __shared__ float red[256];
    const float* h = H + ((size_t)b * TB + CTX + n) * D; float s = 0.f;
    for (int k = tid; k < D; k += 256) s += h[k] * h[k];
    red[tid] = s; __syncthreads(); for (int o = 128; o > 0; o >>= 1) { if (tid < o) red[tid] += red[tid + o]; __syncthreads(); }
    const float rs = rsqrtf(red[0] / D + EPS); for (int k = tid; k < D; k += 256) out[(size_t)i * D + k] = h[k] * rs * g[k];
}

struct Ws { float *mod, *H, *U, *P, *QB, *KVB, *KB, *CQ, *CKV, *OA2, *OCAT, *lbl, *Of, *Ob, *H1, *ACT, *lgate; int *cnt, *off, *list; };
__host__ inline size_t carve(char* base, Ws& w) {
    size_t off = 0; auto take = [&](size_t bytes) { char* p = base + off; off += (bytes + 255) / 256 * 256; return p; };
    w.mod = (float*)take((size_t)DEPTH * 3 * 6 * D * 4); w.H = (float*)take((size_t)R * D * 4); w.U = (float*)take((size_t)R * D * 4);
    w.P = (float*)take((size_t)R * CP * 4); w.QB = (float*)take((size_t)R * 768 * 4); w.KVB = (float*)take((size_t)R * 1024 * 4); w.KB = (float*)take((size_t)R * 768 * 4);
    w.CQ = (float*)take((size_t)R * 256 * 4); w.CKV = (float*)take((size_t)R * 128 * 4); w.OA2 = (float*)take((size_t)R * 1024 * 4); w.OCAT = (float*)take((size_t)R * 1024 * 4);
    w.lbl = (float*)take(D * 4); w.Of = (float*)take((size_t)R * D * 4); w.Ob = (float*)take((size_t)R * D * 4);
    w.cnt = (int*)take(NE * 4); w.off = (int*)take(NE * 4); w.list = (int*)take((size_t)NE * R * 4); w.lgate = (float*)take((size_t)NE * R * 4);
    w.H1 = (float*)take((size_t)4 * R * 2048 * 4); w.ACT = (float*)take((size_t)4 * R * 1024 * 4); return off;
}
}
namespace orc {
inline void run_oracle(void* const* d_in, float* out, char* wsbase, hipStream_t st, float* snap) {
    Ws w; carve(wsbase, w);
    auto in = [&](int i) { return (const float*)d_in[i]; };
    const size_t HB = (size_t)R * D * 4;
    k_ada<<<(DEPTH * 18 * D + 255) / 256, 256, 0, st>>>(in(I_C), in(I_CCTX), in(I_WADA), in(I_BADA), w.mod);
    k_init_h<<<(int)(((size_t)R * D + 255) / 256), 256, 0, st>>>(in(I_X), in(I_CTX), w.H);
    for (int l = 0; l < DEPTH; ++l) {
        const int j = l / 2; const bool last = l == DEPTH - 1; const float* mod_l = w.mod + (size_t)l * 18 * D;
        if (snap) hipMemcpyAsync(snap + (size_t)(2 * l) * R * D, w.H, HB, hipMemcpyDeviceToDevice, st);
        k_norm_mod<<<R, 256, 0, st>>>(w.H, in(I_NMG) + l * D, mod_l, 0, D, w.U);
        if (l % 2 == 0) {
            const float lam_init = 0.8f - 0.6f * expf(-0.3f * (float)l);
            { GArgs g{}; g.A = w.U; g.lda = D; g.M = R; g.B = in(I_WINAB) + (size_t)j * D * ABP; g.ldb = ABP; g.N = ABP; g.K = D; g.C = w.P; g.ldc = ABP; g.epi = 0;
              k_gemm<<<dim3((ABP + 63) / 64, R / 64, 1), 256, 0, st>>>(g); }
            k_rope<<<(R * 8 * 32 + 255) / 256, 256, 0, st>>>(w.P, ABP, 0, 8, 64);
            k_rope<<<(R * 8 * 32 + 255) / 256, 256, 0, st>>>(w.P, ABP, 512, 8, 64);
            k_rope<<<(R * 1 * 32 + 255) / 256, 256, 0, st>>>(w.P, ABP, 1920, 1, 64);
            k_rmsnorm_cols<<<R, 64, 0, st>>>(w.P, ABP, 1536, 256, in(I_QNG) + j * 256, w.CQ);
            k_rmsnorm_cols<<<R, 64, 0, st>>>(w.P, ABP, 1792, 128, in(I_KVNG) + j * 128, w.CKV);
            { GArgs g{}; g.A = w.CQ; g.lda = 256; g.M = R; g.B = in(I_WUQ) + (size_t)j * 256 * 768; g.ldb = 768; g.N = 768; g.K = 256; g.C = w.QB; g.ldc = 768; g.epi = 0;
              k_gemm<<<dim3(768 / 64, R / 64, 1), 256, 0, st>>>(g); }
            { GArgs g{}; g.A = w.CKV; g.lda = 128; g.M = R; g.B = in(I_WUKV) + (size_t)j * 128 * 1024; g.ldb = 1024; g.N = 1024; g.K = 128; g.C = w.KVB; g.ldc = 1024; g.epi = 0;
              k_gemm<<<dim3(1024 / 64, R / 64, 1), 256, 0, st>>>(g); }
            k_rope<<<(R * 4 * 32 + 255) / 256, 256, 0, st>>>(w.QB, 768, 128, 4, 192);
            k_build_kb<<<(int)(((size_t)R * 768 + 255) / 256), 256, 0, st>>>(w.KVB, w.P, w.KB);
            { AArgs a{}; a.Q = w.P; a.ldq = ABP; a.qoff = 0; a.qhs = 64; a.K = w.P; a.ldk = ABP; a.koff = 512; a.khs = 64; a.V = w.P; a.ldv = ABP; a.voff = 1024; a.vhs = 128; a.vdiv = 2;
              a.O = w.OA2; a.ldo = 1024; a.ooff = 0; a.ohs = 128; a.dqk = 64; a.scale = A_SCALE; k_attn<<<dim3(TB / 16, 8, BATCH), 256, 0, st>>>(a); }
            { AArgs a{}; a.Q = w.QB; a.ldq = 768; a.qoff = 0; a.qhs = 192; a.K = w.KB; a.ldk = 768; a.koff = 0; a.khs = 192; a.V = w.KVB; a.ldv = 1024; a.voff = 128; a.vhs = 256; a.vdiv = 1;
              a.O = w.OCAT; a.ldo = 1024; a.ooff = 512; a.ohs = 128; a.dqk = 192; a.scale = B_SCALE; k_attn<<<dim3(TB / 16, 4, BATCH), 256, 0, st>>>(a); }
            k_diff_combine<<<dim3(R, 4), 128, 0, st>>>(w.OA2, in(I_DLAM) + j * 256, in(I_SUBLN) + j * 128, lam_init, w.OCAT);
            { GArgs g{}; g.A = w.OCAT; g.lda = D; g.M = R; g.B = in(I_WOUTAB) + (size_t)j * D * D; g.ldb = D; g.N = D; g.K = D; g.C = w.H; g.ldc = D; g.epi = 1; g.mod_l = mod_l; g.gate_off = 2 * D;
              k_gemm<<<dim3(D / 64, R / 64, 1), 256, 0, st>>>(g); }
        } else {
            { GArgs g{}; g.A = w.U; g.lda = D; g.M = R; g.B = in(I_WINC) + (size_t)j * D * CP; g.ldb = CP; g.N = CP; g.K = D; g.C = w.P; g.ldc = CP; g.epi = 0;
              k_gemm<<<dim3(CP / 64, R / 64, 1), 256, 0, st>>>(g); }
            k_lb<<<D / 256, 256, 0, st>>>(in(I_LBRAW), l, w.lbl);
            k_scan<<<dim3(8, 2, BATCH), 128, 0, st>>>(w.P, w.lbl, w.Of, w.Ob);
            k_readout<<<dim3(R, 8), 128, 0, st>>>(w.Of, w.Ob, w.P, in(I_HNG) + j * 128, w.OCAT);
            { GArgs g{}; g.A = w.OCAT; g.lda = D; g.M = R; g.B = in(I_WOUTC) + (size_t)j * D * D; g.ldb = D; g.N = D; g.K = D; g.C = w.H; g.ldc = D; g.epi = 1; g.mod_l = mod_l; g.gate_off = 2 * D;
              k_gemm<<<dim3(D / 64, R / 64, 1), 256, 0, st>>>(g); }
        }
        if (snap) hipMemcpyAsync(snap + (size_t)(2 * l + 1) * R * D, w.H, HB, hipMemcpyDeviceToDevice, st);
        k_norm_mod<<<R, 256, 0, st>>>(w.H, in(I_NFG) + l * D, mod_l, 3 * D, 4 * D, w.U);
        hipMemsetAsync(w.cnt, 0, NE * 4, st);
        k_router<<<R, 64, 0, st>>>(w.U, in(I_WR) + (size_t)l * D * NE, in(I_BR) + l * NE, last ? 1 : 0, w.cnt, w.list, w.lgate);
        k_prefix<<<1, 64, 0, st>>>(w.cnt, w.off);
        { GArgs g{}; g.A = w.U; g.lda = D; g.aidx = w.list; g.cnt = w.cnt; g.B = in(I_W1) + (size_t)l * NE * D * 2048; g.ldb = 2048; g.N = 2048; g.K = D; g.b_stride = (size_t)D * 2048;
          g.C = w.H1; g.ldc = 2048; g.coff = w.off; g.bias = in(I_B1) + (size_t)l * NE * 2048; g.bias_stride = 2048; g.epi = 0;
          k_gemm<<<dim3(2048 / 64, R / 64, NE), 256, 0, st>>>(g); }
        k_swiglu<<<dim3(1024 / 256, R, NE), 256, 0, st>>>(w.H1, w.cnt, w.off, w.ACT);
        { GArgs g{}; g.A = w.ACT; g.lda = 1024; g.aoff = w.off; g.cnt = w.cnt; g.B = in(I_W2) + (size_t)l * NE * 1024 * 1024; g.ldb = 1024; g.N = 1024; g.K = 1024; g.b_stride = (size_t)1024 * 1024;
          g.C = w.H; g.ldc = D; g.bias = in(I_B2) + (size_t)l * NE * 1024; g.bias_stride = 1024; g.epi = 2; g.mod_l = mod_l; g.gate_off = 5 * D; g.rgate = w.lgate; g.list = w.list;
          k_gemm<<<dim3(1024 / 64, R / 64, NE), 256, 0, st>>>(g); }
    }
    if (snap) hipMemcpyAsync(snap + (size_t)8 * R * D, w.H, HB, hipMemcpyDeviceToDevice, st);
    if (out) k_final<<<BATCH * SEQ, 256, 0, st>>>(w.H, in(I_FING), out);
}
}
extern "C" void kernel_launch(void* const* d_in, const int* in_sizes, int n_in, void* d_out, int out_size, void* d_ws, size_t ws_size, hipStream_t stream) {
    orc::run_oracle(d_in, (float*)d_out, (char*)d_ws, stream, nullptr);
}
```

```cpp
#include <hip/hip_runtime.h>
#include <cstdio>
#include <cstdint>
namespace cfg {
constexpr int D = 1024, BATCH = 2, SEQ = 8192, DEPTH = 4, GRIDW = 64, CTX = 256;
constexpr int TB = CTX + SEQ;
constexpr int R = BATCH * TB;
constexpr int ABP = 1984, CP = 5120, NE = 32;
constexpr float EPS = 1e-6f;
constexpr float A_SCALE = 0.125f;
constexpr float B_SCALE = 0.07216878364870322f;
enum { I_X = 0, I_C, I_CTX, I_CCTX, I_NMG, I_NFG, I_WADA, I_BADA, I_WINAB, I_DLAM, I_SUBLN, I_QNG, I_KVNG, I_WUQ, I_WUKV, I_WOUTAB, I_WINC, I_LBRAW, I_HNG, I_WOUTC,
       I_WR, I_BR, I_W1, I_B1, I_W2, I_B2, I_FING };
}
namespace pg8 {
#define PG8_LAS __attribute__((address_space(3)))
typedef unsigned short bf16_t;
typedef short bf16x8 __attribute__((ext_vector_type(8)));
typedef float f32x4 __attribute__((ext_vector_type(4)));
typedef unsigned u32x4 __attribute__((ext_vector_type(4)));
constexpr int BM = 256, BK = 64, HALF = 128, HTB = HALF * BK * 2  , STAGE_BYTES = 8 * HTB, NXCD = 8, WGM = 8;

__host__ __device__ __forceinline__ int lds_byte(int r, int c) { const int st = (r >> 4) * 2 + (c >> 5), rr = r & 15, cc = c & 31, ob = rr * 64 + cc * 2; return st * 1024 + (ob ^ (((ob >> 9) & 1) << 5)); }
__host__ __device__ __forceinline__ void stage_rc(int b, int& R, int& C) { const int st = b / 1024, sb = b % 1024, swz = sb ^ (((sb >> 9) & 1) << 5); R = (st >> 1) * 16 + swz / 64; C = (st & 1) * 32 + (swz % 64) / 2; }
__host__ __device__ __forceinline__ int perm32(int rho) { const int n = rho >> 4, i = rho & 15; return 8 * (i >> 2) + 4 * n + (i & 3); }

struct Unit { int pm, pn, e; };
struct Gemm { const bf16_t* A; const bf16_t* Bt; int M, N, K; size_t b_estride; };

struct StaticOrder {
    int nM, nN, nwg, G, c;
    __host__ __device__ void init(int M, int N, int G_, int c_) { nM = M / BM; nN = N / BM; nwg = nM * nN; G = G_; c = c_; }
    __host__ __device__ bool next(int i, Unit& u) const {
        const long L = (long)i * G + c; if (L >= nwg) return false;
        int wgid = (int)L; { const int q = nwg / NXCD, r = nwg % NXCD, xcd = wgid % NXCD, off = wgid / NXCD; wgid = (xcd < r ? xcd * (q + 1) : r * (q + 1) + (xcd - r) * q) + off; }
        const int nig = WGM * nN, gid = wgid / nig, fm = gid * WGM, gsz = (nM - fm) < WGM ? (nM - fm) : WGM;
        u.pm = fm + ((wgid % nig) % gsz); u.pn = (wgid % nig) / gsz; u.e = 0; return true;
    }
    __device__ __forceinline__ void a_ready(const Unit&) const {}
    __device__ __forceinline__ void done(const Unit&) const {}
};

__device__ __forceinline__ unsigned cvt_pk_bf16(float lo, float hi) { unsigned r; asm volatile("v_cvt_pk_bf16_f32 %0, %1, %2" : "=v"(r) : "v"(lo), "v"(hi)); return r; }
typedef float f32x2 __attribute__((ext_vector_type(2)));
__device__ __forceinline__ f32x2 gelu_pk(f32x2 v) {
    const f32x2 av = __builtin_elementwise_abs(v), d = av * 0.2316418882f + 1.0f;
    f32x2 t; t.x = __builtin_amdgcn_rcpf(d.x); t.y = __builtin_amdgcn_rcpf(d.y);
    f32x2 q = t * 0.5307027145f + (-0.7265760135f); q = q * t + 0.7107068705f; q = q * t + (-0.142248368f); q = q * t + 0.127414796f; q = q * t;
    const f32x2 s = (v * v) * (-0.72134752044f);
    f32x2 e; e.x = __builtin_amdgcn_exp2f(s.x); e.y = __builtin_amdgcn_exp2f(s.y);
    const f32x2 m = v * (q * e), r = v - m;
    f32x2 o; o.x = v.x < 0.f ? m.x : r.x; o.y = v.y < 0.f ? m.y : r.y; return o;
}

template <int ACT  > struct EpiBf16 {
    static constexpr bool PERM = true, AFTER_DRAIN = false; static_assert(ACT == 0 || ACT == 1, "EpiBf16: ACT is 0 (none) or 1 (gelu_pk)");
    bf16_t* O; int ldc; const float* bias; int split_cols; size_t split_stride; float scale0;
    __device__ __forceinline__ void operator()(const f32x4 (&acc)[2][2][4][2], const Unit& u, int wr, int wc, int fr, int fq) const {
        const int row0 = u.pm * BM + wr * 64 + fr; int colt = u.pn * BM; bf16_t* base = O;
        float sc = 1.f; if (split_cols) { const int t = colt / split_cols; base += (size_t)t * split_stride; colt -= t * split_cols; if (t == 0) sc = scale0; }
        const int col0 = colt + wc * 32 + 8 * fq, bcol0 = u.pn * BM + wc * 32 + 8 * fq;
        f32x4 bv[2][2];
#pragma unroll
        for (int bj = 0; bj < 2; ++bj)
#pragma unroll
            for (int n = 0; n < 2; ++n) bv[bj][n] = bias ? *(const f32x4*)(bias + bcol0 + bj * HALF + 4 * n) : (f32x4){0.f, 0.f, 0.f, 0.f};
#pragma unroll
        for (int ai = 0; ai < 2; ++ai)
#pragma unroll
            for (int m = 0; m < 4; ++m) { bf16_t* rowp = base + (size_t)(row0 + ai * HALF + m * 16) * ldc + col0;
#pragma unroll
                for (int bj = 0; bj < 2; ++bj) { f32x4 v0 = acc[ai][bj][m][0] + bv[bj][0], v1 = acc[ai][bj][m][1] + bv[bj][1];
                    if (ACT == 1) { f32x2 a = gelu_pk((f32x2){v0[0], v0[1]}), b = gelu_pk((f32x2){v0[2], v0[3]}), c = gelu_pk((f32x2){v1[0], v1[1]}), d = gelu_pk((f32x2){v1[2], v1[3]});
                        v0 = (f32x4){a.x, a.y, b.x, b.y}; v1 = (f32x4){c.x, c.y, d.x, d.y}; }
                    v0 = v0 * sc; v1 = v1 * sc; u32x4 w; w.x = cvt_pk_bf16(v0[0], v0[1]); w.y = cvt_pk_bf16(v0[2], v0[3]); w.z = cvt_pk_bf16(v1[0], v1[1]); w.w = cvt_pk_bf16(v1[2], v1[3]);
                    *(u32x4*)(rowp + bj * HALF) = w; } }
    }
};

__device__ __forceinline__ int panel_mod(int pm) { return (pm % 33 == 0) ? 2 : pm / 33; }
struct EpiResid {
    static constexpr bool PERM = false, AFTER_DRAIN = false;
    float* H; const float* gate;
    __device__ __forceinline__ void operator()(const f32x4 (&acc)[2][2][4][2], const Unit& u, int wr, int wc, int fr, int fq) const {
        const int col0 = u.pn * BM + wc * 32 + 4 * fq; const float* g = gate + panel_mod(u.pm) * 6144 + col0;
        f32x4 gv[2][2];
#pragma unroll
        for (int bj = 0; bj < 2; ++bj)
#pragma unroll
            for (int n = 0; n < 2; ++n) gv[bj][n] = *(const f32x4*)(g + bj * HALF + n * 16);
#pragma unroll
        for (int ai = 0; ai < 2; ++ai)
#pragma unroll
            for (int m = 0; m < 4; ++m) { float* rowp = H + (size_t)(u.pm * BM + ai * HALF + wr * 64 + m * 16 + fr) * 1024 + col0;
#pragma unroll
                for (int bj = 0; bj < 2; ++bj)
#pragma unroll
                    for (int n = 0; n < 2; ++n) { f32x4* p = (f32x4*)(rowp + bj * HALF + n * 16); *p = *p + gv[bj][n] * acc[ai][bj][m][n]; } }
    }
};
struct EpiSwiglu {
    static constexpr bool PERM = true, AFTER_DRAIN = false;
    bf16_t* ACT; const float* b1;
    static __device__ __forceinline__ float act(float g, float l) { g = fminf(g, 7.f); l = fminf(fmaxf(l, -7.f), 7.f);
        const float s = __builtin_amdgcn_rcpf(1.f + __builtin_amdgcn_exp2f(-1.702f * 1.4426950408889634f * g)); return g * s * (l + 1.f); }
    __device__ __forceinline__ void operator()(const f32x4 (&acc)[2][2][4][2], const Unit& u, int wr, int wc, int fr, int fq) const {
        const int col0 = u.pn * BM + wc * 32 + 8 * fq; const float* b = b1 + (size_t)u.e * 2048 + col0;
        f32x4 bv[2][2];
#pragma unroll
        for (int bj = 0; bj < 2; ++bj)
#pragma unroll
            for (int n = 0; n < 2; ++n) bv[bj][n] = *(const f32x4*)(b + bj * HALF + 4 * n);
#pragma unroll
        for (int ai = 0; ai < 2; ++ai)
#pragma unroll
            for (int m = 0; m < 4; ++m) { bf16_t* rowp = ACT + (size_t)(u.pm * BM + ai * HALF + wr * 64 + m * 16 + fr) * 1024 + col0 / 2;
#pragma unroll
                for (int bj = 0; bj < 2; ++bj) { const f32x4 v0 = acc[ai][bj][m][0] + bv[bj][0], v1 = acc[ai][bj][m][1] + bv[bj][1];
                    typedef unsigned u32x2v __attribute__((ext_vector_type(2))); u32x2v w;
                    w.x = cvt_pk_bf16(act(v0[0], v0[1]), act(v0[2], v0[3])); w.y = cvt_pk_bf16(act(v1[0], v1[1]), act(v1[2], v1[3]));
                    *(u32x2v*)(rowp + bj * (HALF / 2)) = w; } }
    }
};
struct EpiBiasE {
    static constexpr bool PERM = true, AFTER_DRAIN = false;
    bf16_t* O; const float* b2;
    __device__ __forceinline__ void operator()(const f32x4 (&acc)[2][2][4][2], const Unit& u, int wr, int wc, int fr, int fq) const {
        const int col0 = u.pn * BM + wc * 32 + 8 * fq; const float* b = b2 + (size_t)u.e * 1024 + col0;
        f32x4 bv[2][2];
#pragma unroll
        for (int bj = 0; bj < 2; ++bj)
#pragma unroll
            for (int n = 0; n < 2; ++n) bv[bj][n] = *(const f32x4*)(b + bj * HALF + 4 * n);
#pragma unroll
        for (int ai = 0; ai < 2; ++ai)
#pragma unroll
            for (int m = 0; m < 4; ++m) { bf16_t* rowp = O + (size_t)(u.pm * BM + ai * HALF + wr * 64 + m * 16 + fr) * 1024 + col0;
#pragma unroll
                for (int bj = 0; bj < 2; ++bj) { const f32x4 v0 = acc[ai][bj][m][0] + bv[bj][0], v1 = acc[ai][bj][m][1] + bv[bj][1];
                    u32x4 w; w.x = cvt_pk_bf16(v0[0], v0[1]); w.y = cvt_pk_bf16(v0[2], v0[3]); w.z = cvt_pk_bf16(v1[0], v1[1]); w.w = cvt_pk_bf16(v1[2], v1[3]);
                    *(u32x4*)(rowp + bj * HALF) = w; } }
    }
};
struct ADense {
    static constexpr bool PER_UNIT = false;
    __device__ __forceinline__ const char* base(const Gemm& g, const Unit& u) const { return (const char*)g.A + (size_t)u.pm * 2 * HALF * g.K * 2; }
    __device__ __forceinline__ void voff(const Gemm& g, const Unit&, int tid, unsigned (&v)[2][2]) const {
#pragma unroll
        for (int i = 0; i < 2; ++i) { int R, C; stage_rc(tid * 16 + i * 8192, R, C);
#pragma unroll
            for (int h = 0; h < 2; ++h) v[h][i] = (unsigned)((h * HALF + R) * g.K + C) * 2u; } }
};
struct AGather {
    static constexpr bool PER_UNIT = true;
    const int* rowidx;
    __device__ __forceinline__ const char* base(const Gemm& g, const Unit&) const { return (const char*)g.A; }
    __device__ __forceinline__ void voff(const Gemm& g, const Unit& u, int tid, unsigned (&v)[2][2]) const {
#pragma unroll
        for (int i = 0; i < 2; ++i) { int R, C; stage_rc(tid * 16 + i * 8192, R, C);
#pragma unroll
            for (int h = 0; h < 2; ++h) v[h][i] = (unsigned)(rowidx[u.pm * BM + h * HALF + R] * g.K + C) * 2u; } }
};
struct MoeOrder {
    int ntiles, npn, G, c; const PG8_LAS unsigned char* tile_e;
    __device__ __forceinline__ bool next(int i, Unit& u) const { const int L = i * G + c; if (L >= ntiles * npn) return false; u.pm = L / npn; u.pn = L % npn; u.e = tile_e[u.pm]; return true; }
    __device__ __forceinline__ void a_ready(const Unit&) const {}
    __device__ __forceinline__ void done(const Unit&) const {}
};

template <class Epi, class Sched, class ASrc, bool ALIGN_EPI>
__device__ __forceinline__ void gemm_phase(PG8_LAS unsigned char* lds, const Gemm g, const Sched& S, const Epi& E, const ASrc& AS) {
    int tid_ = threadIdx.x; asm volatile("" : "+v"(tid_));
    const int tid = tid_, wid = __builtin_amdgcn_readfirstlane(tid >> 6), lane = tid & 63, wr = wid >> 2, wc = wid & 3, fr = lane & 15, fq = lane >> 4;
    const int K = g.K, nt = K / BK;
    unsigned voffB[2];
#pragma unroll
    for (int i = 0; i < 2; ++i) { int R, C; stage_rc(tid * 16 + i * 8192, R, C); const int Rb = Epi::PERM ? ((R & ~31) + perm32(R & 31)) : R; voffB[i] = (unsigned)(Rb * K + C) * 2u; }
    const size_t kstep = (size_t)(BK * 2);
    const size_t hstep = (size_t)HALF * K * 2;
    const size_t tstep = 2 * hstep;
    const unsigned ldsw = (unsigned)wid * 1024u;
    const int aoff = lds_byte(wr * 64 + fr, fq * 8), boff = lds_byte(wc * 32 + fr, fq * 8);
#define PG8_SA(b, h) (((b) * 2 + (h)) * HTB)
#define PG8_SB(b, h) ((4 + (b) * 2 + (h)) * HTB)
#define PG8_STAGE(bufoff, gbase, voff) do { _Pragma("unroll") for (int _i = 0; _i < 2; ++_i) \
        __builtin_amdgcn_global_load_lds((const unsigned*)((const char*)(gbase) + (voff)[_i]), (PG8_LAS unsigned*)(lds + (bufoff) + ldsw + _i * 8192), 16, 0, 0); } while (0)
#define PG8_STAGE_A(bufoff, isnext, kofs, h) do { const char* _b = ((isnext) ? nA : cA) + (kofs); _Pragma("unroll") for (int _i = 0; _i < 2; ++_i) { const unsigned _v = (ASrc::PER_UNIT && (isnext)) ? voffN[h][_i] : voffC[h][_i]; \
        __builtin_amdgcn_global_load_lds((const unsigned*)(_b + _v), (PG8_LAS unsigned*)(lds + (bufoff) + ldsw + _i * 8192), 16, 0, 0); } } while (0)
#define PG8_LDA(dst, b, h) do { _Pragma("unroll") for (int m = 0; m < 4; ++m) _Pragma("unroll") for (int k = 0; k < 2; ++k) dst[m][k] = *(const PG8_LAS bf16x8*)(lds + PG8_SA(b, h) + aoff + m * 2048 + k * 1024); } while (0)
#define PG8_LDB(dst, b, h) do { _Pragma("unroll") for (int n = 0; n < 2; ++n) _Pragma("unroll") for (int k = 0; k < 2; ++k) dst[n][k] = *(const PG8_LAS bf16x8*)(lds + PG8_SB(b, h) + boff + n * 2048 + k * 1024); } while (0)
#define PG8_MMA(ai, bj, At, Bt) do { __builtin_amdgcn_s_setprio(1); _Pragma("unroll") for (int m = 0; m < 4; ++m) _Pragma("unroll") for (int n = 0; n < 2; ++n) _Pragma("unroll") for (int k = 0; k < 2; ++k) \
        acc[ai][bj][m][n] = __builtin_amdgcn_mfma_f32_16x16x32_bf16(Bt[n][k], At[m][k], acc[ai][bj][m][n], 0, 0, 0); __builtin_amdgcn_s_setprio(0); } while (0)
#define PG8_WAIT_V(n) asm volatile("s_waitcnt vmcnt(" #n ")" ::: "memory")
#define PG8_WAIT_L(n) asm volatile("s_waitcnt lgkmcnt(" #n ")" ::: "memory")
#define PG8_BAR __builtin_amdgcn_s_barrier()
#define PG8_SCHED __builtin_amdgcn_sched_barrier(0)
    Unit cur, nxt; int ui = 0;
    if (!S.next(0, cur)) return;
    f32x4 acc[2][2][4][2];
#pragma unroll
    for (int a = 0; a < 2; ++a)
#pragma unroll
        for (int b = 0; b < 2; ++b)
#pragma unroll
            for (int m = 0; m < 4; ++m)
#pragma unroll
                for (int n = 0; n < 2; ++n) acc[a][b][m][n] = (f32x4){0.f, 0.f, 0.f, 0.f};
    bf16x8 At[4][2], B0[2][2], B1[2][2];
    unsigned voffC[2][2], voffN[2][2];
    const char* cA = AS.base(g, cur); const char* cB = (const char*)g.Bt + (size_t)cur.e * g.b_estride + (size_t)cur.pn * tstep;
    AS.voff(g, cur, tid, voffC);
    const char* nA = cA; const char* nB = cB;
#pragma unroll
    for (int h = 0; h < 2; ++h)
#pragma unroll
        for (int i = 0; i < 2; ++i) voffN[h][i] = voffC[h][i];
    PG8_STAGE(PG8_SB(0, 0), cB, voffB); PG8_STAGE(PG8_SB(0, 1), cB + hstep, voffB); PG8_STAGE_A(PG8_SA(0, 0), false, 0, 0); PG8_STAGE_A(PG8_SA(0, 1), false, 0, 1);
    if (wr == 1) PG8_BAR;
    PG8_WAIT_V(2); PG8_BAR;
    PG8_STAGE(PG8_SB(1, 0), cB + kstep, voffB); PG8_STAGE_A(PG8_SA(1, 0), false, kstep, 0); PG8_STAGE(PG8_SB(1, 1), cB + hstep + kstep, voffB);
    PG8_WAIT_V(6); PG8_BAR;
    for (;;) {
        const bool has_next = S.next(ui + 1, nxt);
        nA = cA; nB = cB;
#pragma unroll
        for (int h = 0; h < 2; ++h)
#pragma unroll
            for (int i = 0; i < 2; ++i) voffN[h][i] = voffC[h][i];
        if (has_next) { nA = AS.base(g, nxt); nB = (const char*)g.Bt + (size_t)nxt.e * g.b_estride + (size_t)nxt.pn * tstep; if constexpr (ASrc::PER_UNIT) AS.voff(g, nxt, tid, voffN); }
        for (int t = 0; t < nt; t += 2) {
            const bool last = (t == nt - 2);
            const size_t k1 = (size_t)(t + 1) * kstep;
            const size_t k2 = last ? 0 : (size_t)(t + 2) * kstep, k3 = k2 + kstep;
            const char* b2 = last ? nB : cB + (size_t)(t + 2) * kstep; const char* b3 = b2 + kstep;
            PG8_LDB(B0, 0, 0); PG8_LDB(B1, 0, 1); PG8_SCHED; PG8_LDA(At, 0, 0); PG8_STAGE_A(PG8_SA(1, 1), false, k1, 1);
            PG8_WAIT_V(8); PG8_WAIT_L(0); PG8_BAR; PG8_MMA(0, 0, At, B0); PG8_MMA(0, 1, At, B1); PG8_BAR; PG8_SCHED;
            PG8_LDA(At, 0, 1); PG8_STAGE(PG8_SB(0, 0), b2, voffB); PG8_STAGE(PG8_SB(0, 1), b2 + hstep, voffB); PG8_STAGE_A(PG8_SA(0, 0), last, k2, 0);
            PG8_WAIT_V(8); PG8_WAIT_L(0); PG8_BAR; PG8_MMA(1, 0, At, B0); PG8_MMA(1, 1, At, B1); PG8_BAR; PG8_SCHED;
            PG8_LDB(B0, 1, 0); PG8_LDB(B1, 1, 1); PG8_SCHED; PG8_LDA(At, 1, 0); PG8_STAGE_A(PG8_SA(0, 1), last, k2, 1);
            PG8_WAIT_V(8); PG8_WAIT_L(0); PG8_BAR; PG8_MMA(0, 0, At, B0); PG8_MMA(0, 1, At, B1); PG8_BAR; PG8_SCHED;
            PG8_LDA(At, 1, 1); PG8_STAGE(PG8_SB(1, 0), b3, voffB); PG8_STAGE(PG8_SB(1, 1), b3 + hstep, voffB); PG8_STAGE_A(PG8_SA(1, 0), last, k3, 0);
            PG8_WAIT_V(8); PG8_WAIT_L(0); PG8_BAR; PG8_MMA(1, 0, At, B0); PG8_MMA(1, 1, At, B1); PG8_BAR; PG8_SCHED;
        }
        if constexpr (ALIGN_EPI) { if (wr == 0) PG8_BAR; }
        E(acc, cur, wr, wc, fr, fq);
        if (!has_next) break;
#pragma unroll
        for (int a = 0; a < 2; ++a)
#pragma unroll
            for (int b = 0; b < 2; ++b)
#pragma unroll
                for (int m = 0; m < 4; ++m)
#pragma unroll
                    for (int n = 0; n < 2; ++n) acc[a][b][m][n] = (f32x4){0.f, 0.f, 0.f, 0.f};
        cur = nxt; cA = nA; cB = nB; ++ui;
#pragma unroll
        for (int h = 0; h < 2; ++h)
#pragma unroll
            for (int i = 0; i < 2; ++i) voffC[h][i] = voffN[h][i];
        if constexpr (ALIGN_EPI) { if (wr == 1) PG8_BAR; }
    }
    PG8_WAIT_V(0);
    if constexpr (!ALIGN_EPI) { if (wr == 0) PG8_BAR; }
    PG8_BAR;
#undef PG8_SA
#undef PG8_SB
#undef PG8_STAGE
#undef PG8_STAGE_A
#undef PG8_LDA
#undef PG8_LDB
#undef PG8_MMA
#undef PG8_WAIT_V
#undef PG8_WAIT_L
#undef PG8_BAR
#undef PG8_SCHED
}
}
namespace mk {
using namespace cfg;
#define GAS __attribute__((address_space(1)))
#define LAS __attribute__((address_space(3)))
typedef unsigned short bf16;
typedef unsigned v4u __attribute__((ext_vector_type(4)));
typedef unsigned v2u __attribute__((ext_vector_type(2)));
typedef float f32x4 __attribute__((ext_vector_type(4)));
typedef float f32x2 __attribute__((ext_vector_type(2)));
typedef short bf16x8 __attribute__((ext_vector_type(8)));
constexpr int NWAVES = 8, NTHR = 512;
constexpr int NSLOT = 75776;
constexpr int MAXTILES = NSLOT / 256;
constexpr size_t al(size_t x) { return (x + 255) / 256 * 256; }
constexpr size_t WS_CTL = 0, CTL_ZERO_BYTES = 1u << 20;
constexpr int CW_BAR = 4096;
constexpr size_t WS_MOD = 65536;
constexpr size_t WS_LBL = 1u << 20;
constexpr size_t WS_ROPE = WS_LBL + 16384;
constexpr size_t WS_SEG = WS_ROPE + 16384;
constexpr size_t WS_CNTBLK = WS_SEG + 256;
constexpr size_t WS_TOPI = al(WS_CNTBLK + 256 * 32 * 4);
constexpr size_t WS_TOPG = al(WS_TOPI + (size_t)R * 16);
constexpr size_t WS_LRANK = al(WS_TOPG + (size_t)R * 16);
constexpr size_t WS_SLOTOF = al(WS_LRANK + (size_t)R * 16);
constexpr size_t WS_ROWIDX = al(WS_SLOTOF + (size_t)R * 16);
constexpr size_t WS_WINAB = al(WS_ROWIDX + (size_t)NSLOT * 4);
constexpr size_t WS_WUP = al(WS_WINAB + (size_t)2 * 2048 * 1024 * 2);
constexpr size_t WS_WOUTAB = al(WS_WUP + (size_t)2 * 1792 * 384 * 2);
constexpr size_t WS_WINC = al(WS_WOUTAB + (size_t)2 * 1024 * 1024 * 2);
constexpr size_t WS_WOUTC = al(WS_WINC + (size_t)2 * 5120 * 1024 * 2);
constexpr size_t WS_W1 = al(WS_WOUTC + (size_t)2 * 1024 * 1024 * 2);
constexpr size_t WS_W2 = al(WS_W1 + (size_t)4 * 32 * 2048 * 1024 * 2);
constexpr size_t WS_H = al(WS_W2 + (size_t)4 * 32 * 1024 * 1024 * 2);
constexpr size_t WS_U = al(WS_H + (size_t)R * 1024 * 4);
constexpr size_t WS_P = al(WS_U + (size_t)R * 1024 * 2);
constexpr size_t WS_CQKV = al(WS_P + (size_t)R * 5120 * 2);
constexpr size_t WS_QKVB = al(WS_CQKV + (size_t)R * 384 * 2);
constexpr size_t WS_OA2 = al(WS_QKVB + (size_t)R * 1856 * 2);
constexpr size_t WS_OCAT = al(WS_OA2 + (size_t)R * 1024 * 2);
constexpr size_t WS_ACT = al(WS_OCAT + (size_t)R * 1024 * 2);
constexpr size_t WS_YB = al(WS_ACT + (size_t)NSLOT * 1024 * 2);
constexpr size_t WS_SCAN = al(WS_YB + (size_t)NSLOT * 1024 * 2);
constexpr size_t WS_SC_OLOC = WS_SCAN;
constexpr size_t WS_SC_QF = al(WS_SC_OLOC + (size_t)R * 1024 * 4);
constexpr size_t WS_SC_QB = al(WS_SC_QF + (size_t)R * 1024 * 2);
constexpr size_t WS_SC_KV = al(WS_SC_QB + (size_t)R * 1024 * 2);
constexpr size_t WS_SC_DEC = al(WS_SC_KV + (size_t)2 * 2 * 8 * 33 * 16384 * 4);
constexpr size_t WS_MODP = al(WS_SC_DEC + (size_t)2 * 2 * 8 * 33 * 128 * 4);
constexpr size_t WS_END = al(WS_MODP + (size_t)4 * DEPTH * 18 * D * 4);
constexpr int RING_OFF = 0, RING_BYTES = 131072, LDSCTL_OFF = RING_BYTES, LDS_BYTES = 147456;
constexpr int LC_BAR = 0, LC_HIST = 64, LC_SEG = 256, LC_TILEE = 512, LC_MISC = 1024;

#define RLX_AGENT __ATOMIC_RELAXED, __HIP_MEMORY_SCOPE_AGENT
#define LDS_WAIT() asm volatile("s_waitcnt lgkmcnt(0)" ::: "memory")
#define VM_WAIT() asm volatile("s_waitcnt vmcnt(0)" ::: "memory")
__device__ __forceinline__ unsigned f2bf(float f) { unsigned u = __builtin_bit_cast(unsigned, f); return (u + 0x7fffu + ((u >> 16) & 1u)) >> 16; }
__device__ __forceinline__ unsigned pk2(float lo, float hi) { return f2bf(lo) | (f2bf(hi) << 16); }
__device__ __forceinline__ float bflo(unsigned w) { return __builtin_bit_cast(float, w << 16); }
__device__ __forceinline__ float bfhi(unsigned w) { return __builtin_bit_cast(float, w & 0xffff0000u); }
__device__ __forceinline__ float wave_sum_l(float v, int lane) {
#pragma unroll
    for (int o = 1; o < 64; o <<= 1) v += __builtin_bit_cast(float, __builtin_amdgcn_ds_bpermute((lane ^ o) << 2, __builtin_bit_cast(int, v)));
    return v;
}
#define wave_sum(v) wave_sum_l((v), F.lane)
__device__ __forceinline__ float siluf(float x) { return x / (1.f + __expf(-x)); }
__device__ __forceinline__ int row_mod(int r) { const int b = r / TB, t = r - b * TB; return t < CTX ? 2 : b; }

#define XB_TMO      128
#define XB_XCNT(j)  (256  + 64 * (j))
#define XB_XSUB(j)  (1280 + 64 * (j))
#define XB_XGEN(j)  (2304 + 64 * (j))
#define XB_TOP      3328
#define XB_TOPGEN   3392
#define XCD_BAR_WORDS 3456
#define XB_SPIN_CAP (1u << 18)
constexpr size_t XCD_BAR_WORDS_BYTES = XCD_BAR_WORDS * 4;
__device__ __forceinline__ unsigned xb_ld(unsigned* p)              { return __hip_atomic_load(p, __ATOMIC_RELAXED, __HIP_MEMORY_SCOPE_AGENT); }
__device__ __forceinline__ unsigned xb_add(unsigned* p, unsigned v) { return __hip_atomic_fetch_add(p, v, __ATOMIC_RELAXED, __HIP_MEMORY_SCOPE_AGENT); }
__device__ __forceinline__ unsigned xb_xcc_id() { return (unsigned)__builtin_amdgcn_s_getreg((3 << 11) | 20) & 0xFu; }
#define XB_SPIN(cond, bar) do { unsigned _sp = 0; while (cond) { __builtin_amdgcn_s_sleep(1); \
    if ((++_sp & 255u) == 0u) { if (xb_ld(&(bar)[XB_TMO])) break; if (_sp > XB_SPIN_CAP) { atomicAdd(&(bar)[XB_TMO], 1u); break; } } } } while (0)
struct XcdBarrier { unsigned* bar; unsigned x; volatile LAS unsigned* st; };
__device__ __forceinline__ XcdBarrier xcd_barrier_post(unsigned* bar, volatile LAS unsigned* st) {
    XcdBarrier b; b.bar = bar; b.x = xb_xcc_id(); b.st = st;
    if (threadIdx.x == 0) (void)xb_add(&bar[XB_XCNT(b.x)], 1u);
    return b;
}
__device__ __forceinline__ void xcd_barrier_complete(unsigned* bar, unsigned x, unsigned& nloc, unsigned& nx) {
    const unsigned G = gridDim.x * gridDim.y * gridDim.z;
    unsigned sum, cnt, mine, sp = 0u;
    for (;;) {
        sum = 0u; cnt = 0u; mine = 0u;
#pragma unroll
        for (unsigned j = 0; j < 16; ++j) { const unsigned c = xb_ld(&bar[XB_XCNT(j)]); sum += c; cnt += (c > 0u) ? 1u : 0u; mine = (j == x) ? c : mine; }
        if (sum == G) break;
        __builtin_amdgcn_s_sleep(1);
        if ((++sp & 255u) == 0u) { if (xb_ld(&bar[XB_TMO])) break; if (sp > XB_SPIN_CAP) { atomicAdd(&bar[XB_TMO], 1u); break; } }
    }
    nloc = mine > 0u ? mine : 1u; nx = cnt > 0u ? cnt : 1u;
}
__device__ __forceinline__ void xcd_barrier(const XcdBarrier& b) {
    asm volatile("s_waitcnt vmcnt(0)" ::: "memory");
    __syncthreads();
    if (threadIdx.x == 0) {
        unsigned* bar = b.bar; unsigned bx = b.x;
        asm volatile("" : "+s"(bar), "+s"(bx));
        __builtin_amdgcn_s_waitcnt(0);
        unsigned nloc = b.st[0], nx = b.st[1];
        if (nloc == 0u) { xcd_barrier_complete(bar, bx, nloc, nx); b.st[0] = nloc; b.st[1] = nx; }
        const unsigned old = xb_add(&bar[XB_XSUB(bx)], 1u);
        const unsigned gen = old / nloc;
        if (old + 1u == (gen + 1u) * nloc) {
            __builtin_amdgcn_fence(__ATOMIC_RELEASE, "agent");
            asm volatile("s_waitcnt vmcnt(0)" ::: "memory");
            const unsigned og = xb_add(&bar[XB_TOP], 1u);
            const unsigned tg = og / nx;
            if (og + 1u == (tg + 1u) * nx) xb_add(&bar[XB_TOPGEN], 1u);
            else XB_SPIN(xb_ld(&bar[XB_TOPGEN]) == tg, bar);
            __builtin_amdgcn_fence(__ATOMIC_ACQUIRE, "agent");
            xb_add(&bar[XB_XGEN(bx)], 1u);
            asm volatile("s_waitcnt vmcnt(0)" ::: "memory");
        } else {
            XB_SPIN(xb_ld(&bar[XB_XGEN(bx)]) == gen, bar);
            __builtin_amdgcn_fence(__ATOMIC_ACQUIRE, "agent");
            asm volatile("s_waitcnt vmcnt(0)" ::: "memory");
        }
    }
    __syncthreads();
}

struct Args { const float* in[27]; float* out; unsigned char* ws; int ph_lo, ph_hi, flags, pad; };
typedef const __attribute__((address_space(4))) Args* CArgs;
__device__ __forceinline__ CArgs get_args() { auto p = __builtin_amdgcn_kernarg_segment_ptr(); asm volatile("" : "+s"(p)); return (CArgs)p; }
struct Frame {
    LAS unsigned char* lds; int tid, lane, wave, vcu, G, gw, NGW;
    unsigned char* ws;
};
__device__ __forceinline__ unsigned char* lnd(unsigned char* p) { asm volatile("" : "+s"(p)); return p; }
__device__ __forceinline__ int lnd_i(int v) { asm volatile("" : "+s"(v)); return v; }
#define WSP(T, off) ((T*)(wsl + (off)))
#define WSL unsigned char* wsl = lnd(F.ws); { int t_ = threadIdx.x; asm volatile("" : "+v"(t_)); F.tid = t_; F.lane = t_ & 63; }

__device__ __forceinline__ void p0_transpose_item(const float* W, int N, bf16* WT, int ldt, int row_off, int col_off, LAS float* scr, int kb, int nb, int lane) {
    const int k0 = 64 * kb, n0 = 32 * nb;
#pragma unroll 8
    for (int i = 0; i < 32; ++i) { const int kk = 2 * i + (lane >> 5); scr[kk * 33 + (lane & 31)] = W[(size_t)(k0 + kk) * N + n0 + (lane & 31)]; }
    LDS_WAIT(); asm volatile("" ::: "memory");
    const int c = lane & 7;
#pragma unroll
    for (int j = 0; j < 4; ++j) { const int n = (lane >> 3) + 8 * j; const LAS float* s = scr + (8 * c) * 33 + n;
        v4u o; o.x = pk2(s[0 * 33], s[1 * 33]); o.y = pk2(s[2 * 33], s[3 * 33]); o.z = pk2(s[4 * 33], s[5 * 33]); o.w = pk2(s[6 * 33], s[7 * 33]);
        *(GAS v4u*)(WT + (size_t)(row_off + n0 + n) * ldt + col_off + k0 + 8 * c) = o; }
    LDS_WAIT(); asm volatile("" ::: "memory");
}
__device__ __forceinline__ void phase_p0(Frame& F, CArgs A) {
    WSL;
    LAS float* scr = (LAS float*)(F.lds + RING_OFF + F.wave * 16384);
    LAS float* sv = (LAS float*)(F.lds + LDSCTL_OFF + LC_MISC);
    for (int i = F.tid; i < 3 * D; i += NTHR) { const int j = i / D, k = i % D; const float v = j < 2 ? A->in[I_C][j * D + k] : A->in[I_CCTX][k]; sv[i] = siluf(v); }
    __syncthreads();
    {
        constexpr int I0 = 16 * 62, I1 = 4 * 24, I2 = 2 * 32, I3 = 16 * 32, I4 = 16 * 160, I5 = 16 * 32, IJ = I0 + I1 + I2 + I3 + I4 + I5;
        for (int it = F.gw; it < 2 * IJ; it += F.NGW) {
            const int j = it / IJ; int r = it % IJ;
            if (r < I0) { p0_transpose_item(A->in[I_WINAB] + (size_t)j * 1024 * 1984, 1984, WSP(bf16, WS_WINAB) + (size_t)j * 2048 * 1024, 1024, 0, 0, scr, r / 62, r % 62, F.lane); continue; } r -= I0;
            if (r < I1) { p0_transpose_item(A->in[I_WUQ] + (size_t)j * 256 * 768, 768, WSP(bf16, WS_WUP) + (size_t)j * 1792 * 384, 384, 0, 0, scr, r / 24, r % 24, F.lane); continue; } r -= I1;
            if (r < I2) { p0_transpose_item(A->in[I_WUKV] + (size_t)j * 128 * 1024, 1024, WSP(bf16, WS_WUP) + (size_t)j * 1792 * 384, 384, 768, 256, scr, r / 32, r % 32, F.lane); continue; } r -= I2;
            if (r < I3) { p0_transpose_item(A->in[I_WOUTAB] + (size_t)j * 1024 * 1024, 1024, WSP(bf16, WS_WOUTAB) + (size_t)j * 1024 * 1024, 1024, 0, 0, scr, r / 32, r % 32, F.lane); continue; } r -= I3;
            if (r < I4) { p0_transpose_item(A->in[I_WINC] + (size_t)j * 1024 * 5120, 5120, WSP(bf16, WS_WINC) + (size_t)j * 5120 * 1024, 1024, 0, 0, scr, r / 160, r % 160, F.lane); continue; } r -= I4;
            p0_transpose_item(A->in[I_WOUTC] + (size_t)j * 1024 * 1024, 1024, WSP(bf16, WS_WOUTC) + (size_t)j * 1024 * 1024, 1024, 0, 0, scr, r / 32, r % 32, F.lane);
        }
        const int gt = F.vcu * NTHR + F.tid, NGT = F.G * NTHR; const v4u z = {0u, 0u, 0u, 0u};
        constexpr int Z0 = 64 * 128, Z1 = 768 * 16, Z2 = 1024 * 32, ZJ = Z0 + Z1 + Z2;
        for (int it = gt; it < 2 * ZJ; it += NGT) { const int j = it / ZJ; int r = it % ZJ;
            if (r < Z0) { *(GAS v4u*)(WSP(bf16, WS_WINAB) + (size_t)j * 2048 * 1024 + (size_t)(1984 + r / 128) * 1024 + (r % 128) * 8) = z; continue; } r -= Z0;
            if (r < Z1) { *(GAS v4u*)(WSP(bf16, WS_WUP) + (size_t)j * 1792 * 384 + (size_t)(r / 16) * 384 + 256 + (r % 16) * 8) = z; continue; } r -= Z1;
            *(GAS v4u*)(WSP(bf16, WS_WUP) + (size_t)j * 1792 * 384 + (size_t)(768 + r / 32) * 384 + (r % 32) * 8) = z; }
        for (int it = gt; it < 128 * 16; it += NGT) { const int pos = it / 16, fi = it % 16; const float inv = powf(10000.f, -(float)fi / 16.f); float sn, cs; sincosf((float)pos * inv, &sn, &cs);
            WSP(f32x2, WS_ROPE)[it] = (f32x2){cs, sn}; }
        for (int it = gt; it < D; it += NGT) { const float* lr = A->in[I_LBRAW]; float mx = -1e30f; for (int i = 0; i < DEPTH; ++i) mx = fmaxf(mx, lr[i * D + it]);
            float e[DEPTH], s = 0.f; for (int i = 0; i < DEPTH; ++i) { e[i] = expf(lr[i * D + it] - mx); s += e[i]; }
            float acc = 0.f; WSP(float, WS_LBL)[it] = 0.f; for (int i = 1; i < DEPTH; ++i) { acc += e[i] / s; WSP(float, WS_LBL)[i * D + it] = acc; } }
    }
    {
        constexpr int NCB = 6 * D / 64;
        for (int it = F.gw; it < DEPTH * NCB * 4; it += F.NGW) { const int kq = it % 4, cb = (it / 4) % NCB, l = it / (4 * NCB);
            const float* w = A->in[I_WADA] + (size_t)l * D * 6 * D + cb * 64 + F.lane; float a0 = 0.f, a1 = 0.f, a2 = 0.f;
#pragma unroll 8
            for (int k = kq * 256; k < kq * 256 + 256; ++k) { const float x = w[(size_t)k * 6 * D]; a0 += sv[k] * x; a1 += sv[D + k] * x; a2 += sv[2 * D + k] * x; }
            float* mp = WSP(float, WS_MODP) + (size_t)kq * DEPTH * 18 * D + (size_t)l * 18 * D + cb * 64 + F.lane;
            mp[0] = a0; mp[6 * D] = a1; mp[12 * D] = a2; }
    }
    {
        constexpr int J1 = 16 * 64, J2 = 16 * 32, JE = J1 + J2;
        for (int it = F.gw; it < DEPTH * NE * JE; it += F.NGW) { const int m = it / JE; int r = it % JE;
            if (r < J1) p0_transpose_item(A->in[I_W1] + (size_t)m * 1024 * 2048, 2048, WSP(bf16, WS_W1) + (size_t)m * 2048 * 1024, 1024, 0, 0, scr, r / 64, r % 64, F.lane);
            else { r -= J1; p0_transpose_item(A->in[I_W2] + (size_t)m * 1024 * 1024, 1024, WSP(bf16, WS_W2) + (size_t)m * 1024 * 1024, 1024, 0, 0, scr, r / 32, r % 32, F.lane); } }
    }
}

__device__ __forceinline__ void phase_p0b(Frame& F, CArgs A) {
    WSL;
    const int gt = F.vcu * NTHR + F.tid, NGT = F.G * NTHR;
    for (int i = gt; i < DEPTH * 18 * D; i += NGT) { const int l = i / (18 * D), col = i % (6 * D); const float* mp = WSP(float, WS_MODP) + i;
        WSP(float, WS_MOD)[i] = A->in[I_BADA][l * 6 * D + col] + ((mp[0] + mp[(size_t)DEPTH * 18 * D]) + (mp[(size_t)2 * DEPTH * 18 * D] + mp[(size_t)3 * DEPTH * 18 * D])); }
}
__device__ __forceinline__ void phase_nm(Frame& F, CArgs A, int l, int mode) {
    WSL;
    const float* g = (mode & 4) ? A->in[I_FING] : A->in[I_NMG] + l * D;
    const float* modl = WSP(float, WS_MOD) + (size_t)l * 18 * D;
    const float* modp = WSP(float, WS_MOD) + (size_t)(l - 1) * 18 * D;
    for (int r = F.gw; r < R; r += F.NGW) {
        const int b = r / TB, t = r - b * TB, j = t < CTX ? 2 : b;
        if ((mode & 4) && t < CTX) continue;
        f32x4 v[4];
        if (mode & 1) { const float* src = t < CTX ? A->in[I_CTX] + ((size_t)b * CTX + t) * D : A->in[I_X] + ((size_t)b * SEQ + (t - CTX)) * D;
#pragma unroll
            for (int q = 0; q < 4; ++q) v[q] = *(const GAS f32x4*)(src + 4 * F.lane + 256 * q); }
        else {
#pragma unroll
            for (int q = 0; q < 4; ++q) v[q] = *(const GAS f32x4*)(WSP(float, WS_H) + (size_t)r * D + 4 * F.lane + 256 * q); }
        if ((mode & 2) && !((mode & 8) && t < CTX)) {
            const int* so = WSP(int, WS_SLOTOF) + (size_t)r * 4; const float* tg = WSP(float, WS_TOPG) + (size_t)r * 4;
            f32x4 s[4] = {};
#pragma unroll
            for (int k = 0; k < 4; ++k) { const int slot = so[k]; const float gk = tg[k]; const bf16* y = WSP(bf16, WS_YB) + (size_t)slot * D + 4 * F.lane;
#pragma unroll
                for (int q = 0; q < 4; ++q) { const v2u w = *(const GAS v2u*)(y + 256 * q); s[q] += gk * (f32x4){bflo(w.x), bfhi(w.x), bflo(w.y), bfhi(w.y)}; } }
            const float* g2 = modp + j * 6 * D + 5 * D + 4 * F.lane;
#pragma unroll
            for (int q = 0; q < 4; ++q) v[q] += *(const GAS f32x4*)(g2 + 256 * q) * s[q];
        }
        if (!(mode & 4) || (A->flags & 1)) {
#pragma unroll
            for (int q = 0; q < 4; ++q) *(GAS f32x4*)(WSP(float, WS_H) + (size_t)r * D + 4 * F.lane + 256 * q) = v[q]; }
        float ss = 0.f;
#pragma unroll
        for (int q = 0; q < 4; ++q) ss += (v[q].x * v[q].x + v[q].y * v[q].y) + (v[q].z * v[q].z + v[q].w * v[q].w);
        const float rs = rsqrtf(wave_sum(ss) * (1.f / D) + EPS);
        if (mode & 4) { float* o = A->out + ((size_t)b * SEQ + (t - CTX)) * D + 4 * F.lane;
#pragma unroll
            for (int q = 0; q < 4; ++q) *(GAS f32x4*)(o + 256 * q) = v[q] * rs * *(const GAS f32x4*)(g + 4 * F.lane + 256 * q); }
        else { const float* sh = modl + j * 6 * D + 4 * F.lane; const float* sc = sh + D; bf16* u = WSP(bf16, WS_U) + (size_t)r * D + 4 * F.lane;
#pragma unroll
            for (int q = 0; q < 4; ++q) { const f32x4 y = v[q] * rs * *(const GAS f32x4*)(g + 4 * F.lane + 256 * q) * (1.f + *(const GAS f32x4*)(sc + 256 * q)) + *(const GAS f32x4*)(sh + 256 * q);
                v2u w; w.x = pk2(y.x, y.y); w.y = pk2(y.z, y.w); *(GAS v2u*)(u + 256 * q) = w; } }
    }
}

__device__ __forceinline__ int rows_per_wg(int G) { return (R + G - 1) / G; }
__device__ __forceinline__ void phase_m1(Frame& F, CArgs A, int l, bool lat_only) {
    WSL;
    LAS float* wrT = (LAS float*)(F.lds + RING_OFF);
    LAS int* hist = (LAS int*)(F.lds + LDSCTL_OFF + LC_HIST);
    const float* wr = A->in[I_WR] + (size_t)l * D * NE;
    for (int i = F.tid; i < D * NE; i += NTHR) { const int k = i / NE, e = i % NE; wrT[e * D + k] = wr[i]; }
    if (F.tid < NE) hist[F.tid] = 0;
    __syncthreads();
    const float* gf = A->in[I_NFG] + l * D; const float* modl = WSP(float, WS_MOD) + (size_t)l * 18 * D; const float* br = A->in[I_BR] + l * NE;
    const int RPW = rows_per_wg(F.G), r0 = F.vcu * RPW, r1 = min(R, r0 + RPW);
    for (int r = r0 + F.wave; r < r1; r += NWAVES) {
        const int b = r / TB, t = r - b * TB, j = t < CTX ? 2 : b;
        if (lat_only && t < CTX) continue;
        f32x4 v[4]; float ss = 0.f;
#pragma unroll
        for (int q = 0; q < 4; ++q) { v[q] = *(const GAS f32x4*)(WSP(float, WS_H) + (size_t)r * D + 4 * F.lane + 256 * q); ss += (v[q].x * v[q].x + v[q].y * v[q].y) + (v[q].z * v[q].z + v[q].w * v[q].w); }
        const float rs = rsqrtf(wave_sum(ss) * (1.f / D) + EPS);
        const float* sh = modl + j * 6 * D + 3 * D + 4 * F.lane; const float* sc = sh + D; bf16* u = WSP(bf16, WS_U) + (size_t)r * D + 4 * F.lane;
#pragma unroll
        for (int q = 0; q < 4; ++q) { v[q] = v[q] * rs * *(const GAS f32x4*)(gf + 4 * F.lane + 256 * q) * (1.f + *(const GAS f32x4*)(sc + 256 * q)) + *(const GAS f32x4*)(sh + 256 * q);
            v2u w; w.x = pk2(v[q].x, v[q].y); w.y = pk2(v[q].z, v[q].w); *(GAS v2u*)(u + 256 * q) = w; }
        float lg[NE];
#pragma unroll
        for (int eg = 0; eg < NE; eg += 4) {
#pragma unroll
            for (int e = eg; e < eg + 4; ++e) { float a = 0.f;
#pragma unroll
                for (int q = 0; q < 4; ++q) { const f32x4 w4 = *(const LAS f32x4*)(wrT + e * D + 4 * F.lane + 256 * q); a += (v[q].x * w4.x + v[q].y * w4.y) + (v[q].z * w4.z + v[q].w * w4.w); }
                lg[e] = a; }
#pragma unroll
            for (int e = eg; e < eg + 4; ++e) lg[e] = wave_sum(lg[e]) + br[e];
            __builtin_amdgcn_sched_barrier(0);
        }
        int sel[4]; float val[4];
#pragma unroll
        for (int k = 0; k < 4; ++k) { int bi = 0; float bv = -3.0e38f;
#pragma unroll
            for (int e = 0; e < NE; ++e) { bool used = false;
#pragma unroll
                for (int q = 0; q < k; ++q) used |= (sel[q] == e);
                if (!used && lg[e] > bv) { bv = lg[e]; bi = e; } }
            sel[k] = bi; val[k] = bv; }
        float p[4], s = 0.f;
#pragma unroll
        for (int k = 0; k < 4; ++k) { p[k] = __expf(val[k] - val[0]); s += p[k]; }
        if (F.lane < 4) { int e = sel[0]; float pk = p[0];
#pragma unroll
            for (int k = 1; k < 4; ++k) if (F.lane == k) { e = sel[k]; pk = p[k]; }
            const int rank = __hip_atomic_fetch_add(hist + e, 1, __ATOMIC_RELAXED, __HIP_MEMORY_SCOPE_WORKGROUP);
            WSP(int, WS_TOPI)[(size_t)r * 4 + F.lane] = e; WSP(float, WS_TOPG)[(size_t)r * 4 + F.lane] = pk / s; WSP(int, WS_LRANK)[(size_t)r * 4 + F.lane] = rank; }
    }
    __syncthreads();
    if (F.tid < NE) WSP(int, WS_CNTBLK)[F.vcu * NE + F.tid] = hist[F.tid];
}
__device__ __forceinline__ void phase_m2(Frame& F, CArgs A, bool lat_only) {
    WSL;
    LAS int* tot = (LAS int*)(F.lds + RING_OFF); LAS int* base = tot + 64; LAS int* seg = tot + 128; LAS int* part = tot + 256;
    { const int e = F.tid & 31, p = F.tid >> 5; int st = 0, sb = 0;
        for (int w = p; w < F.G; w += 16) { const int c = WSP(int, WS_CNTBLK)[w * NE + e]; st += c; sb += (w < F.vcu) ? c : 0; }
        part[p * 32 + e] = st; part[512 + p * 32 + e] = sb; }
    __syncthreads();
    if (F.tid < 64) { const int e = F.tid & 31, wb = F.tid >> 5; int s2 = 0; for (int p = 0; p < 16; ++p) s2 += part[wb * 512 + p * 32 + e]; (wb ? base : tot)[e] = s2; }
    __syncthreads();
    if (F.tid == 0) { int s = 0; for (int e = 0; e < NE; ++e) { seg[e] = s; s += (tot[e] + 255) / 256 * 256; } seg[NE] = s; }
    __syncthreads();
    if (F.vcu == 0 && F.tid <= NE) { WSP(int, WS_SEG)[F.tid] = seg[F.tid]; if (F.tid == NE) WSP(int, WS_SEG)[NE + 1] = seg[NE] / 256; }
    const int RPW = rows_per_wg(F.G), r0 = F.vcu * RPW, r1 = min(R, r0 + RPW);
    for (int i = F.tid; i < (r1 - r0) * 4; i += NTHR) { const int r = r0 + i / 4, k = i % 4; const int t = r % TB; if (lat_only && t < CTX) continue;
        const int e = WSP(int, WS_TOPI)[(size_t)r * 4 + k], slot = seg[e] + base[e] + WSP(int, WS_LRANK)[(size_t)r * 4 + k];
        WSP(int, WS_SLOTOF)[(size_t)r * 4 + k] = slot; WSP(int, WS_ROWIDX)[slot] = r; }
    if (F.vcu < NE) { const int e = F.vcu; for (int s = seg[e] + tot[e] + F.tid; s < seg[e + 1]; s += NTHR) WSP(int, WS_ROWIDX)[s] = 0; }
}
__device__ __forceinline__ pg8::MoeOrder moe_order(Frame& F, int npn) {
    WSL;
    LAS unsigned char* te = (LAS unsigned char*)(F.lds + LDSCTL_OFF + LC_TILEE); LAS int* seg = (LAS int*)(F.lds + LDSCTL_OFF + LC_SEG);
    if (F.tid < NE + 2) seg[F.tid] = WSP(int, WS_SEG)[F.tid];
    __syncthreads();
    const int ntiles = seg[NE + 1];
    for (int t = F.tid; t < ntiles; t += NTHR) { int e = 0; while (e < NE - 1 && seg[e + 1] <= t * 256) ++e; te[t] = (unsigned char)e; }
    __syncthreads();
    pg8::MoeOrder S; S.ntiles = ntiles; S.npn = npn; S.G = lnd_i(F.G); S.c = lnd_i((int)blockIdx.x); S.tile_e = te; return S;
}
__device__ __forceinline__ void phase_ab_post(Frame& F, CArgs A, int j) {
    WSL;
    const float* gq = A->in[I_QNG] + j * 256; const float* gkv = A->in[I_KVNG] + j * 128; const f32x2* rt = WSP(f32x2, WS_ROPE);
    for (int r = F.gw; r < R; r += F.NGW) {
        bf16* p = WSP(bf16, WS_P) + (size_t)r * 2048; const int t = r % TB;
        bf16* kr = WSP(bf16, WS_QKVB) + (size_t)r * 1856 + 1792;
        if (t >= CTX) { const int n = t - CTX, prow = n / GRIDW, pcol = n % GRIDW;
#pragma unroll
            for (int i = 0; i < 5; ++i) { const int idx = F.lane + 64 * i; if (idx < 288) { const int head = idx >> 5, pp = idx & 31, half = pp >> 4, fi = pp & 15;
                bf16* x = p + (head < 8 ? 512 + head * 64 : 1920) + half * 32 + fi; bf16* y = head < 8 ? x : kr + half * 32 + fi; const f32x2 cs = rt[(half ? pcol : prow) * 16 + fi];
                const float x1 = bflo(x[0]), x2 = bflo(x[16]); y[0] = (bf16)f2bf(x1 * cs.x - x2 * cs.y); y[16] = (bf16)f2bf(x2 * cs.x + x1 * cs.y); } } }
        else { kr[F.lane] = p[1920 + F.lane]; }
        bf16* o = WSP(bf16, WS_CQKV) + (size_t)r * 384;
        { const v2u w = *(const GAS v2u*)(p + 1536 + 4 * F.lane); const f32x4 v = {bflo(w.x), bfhi(w.x), bflo(w.y), bfhi(w.y)};
          const float rs = rsqrtf(wave_sum((v.x * v.x + v.y * v.y) + (v.z * v.z + v.w * v.w)) * (1.f / 256.f) + EPS); const f32x4 g = *(const GAS f32x4*)(gq + 4 * F.lane);
          v2u q; q.x = pk2(v.x * rs * g.x, v.y * rs * g.y); q.y = pk2(v.z * rs * g.z, v.w * rs * g.w); *(GAS v2u*)(o + 4 * F.lane) = q; }
        { const unsigned w = *(const GAS unsigned*)(p + 1792 + 2 * F.lane); const float a = bflo(w), b = bfhi(w);
          const float rs = rsqrtf(wave_sum(a * a + b * b) * (1.f / 128.f) + EPS); const f32x2 g = *(const GAS f32x2*)(gkv + 2 * F.lane);
          *(GAS unsigned*)(o + 256 + 2 * F.lane) = pk2(a * rs * g.x, b * rs * g.y); }
    }
}
__device__ __forceinline__ void phase_diff_combine(Frame& F, CArgs A, int j, int l) {
    WSL;
    const float lam_init = 0.8f - 0.6f * expf(-0.3f * (float)l); const float* dl = A->in[I_DLAM] + j * 256; const float* g = A->in[I_SUBLN] + j * 128;
    const float s1 = wave_sum(dl[F.lane] * dl[64 + F.lane]), s2 = wave_sum(dl[128 + F.lane] * dl[192 + F.lane]); const float lam = expf(s1) - expf(s2) + lam_init;
    const f32x2 gg = *(const GAS f32x2*)(g + 2 * F.lane);
    for (int r = F.gw; r < R; r += F.NGW) { const bf16* a = WSP(bf16, WS_OA2) + (size_t)r * 1024 + 2 * F.lane; bf16* o = WSP(bf16, WS_OCAT) + (size_t)r * 1024 + 2 * F.lane;
#pragma unroll
        for (int h = 0; h < 4; ++h) { const unsigned w1 = *(const GAS unsigned*)(a + (2 * h) * 128), w2 = *(const GAS unsigned*)(a + (2 * h + 1) * 128);
            const float x = bflo(w1) - lam * bflo(w2), y = bfhi(w1) - lam * bfhi(w2); const float rs = rsqrtf(wave_sum(x * x + y * y) * (1.f / 128.f) + EPS) * (1.f - lam_init);
            *(GAS unsigned*)(o + h * 128) = pk2(x * rs * gg.x, y * rs * gg.y); } }
}
namespace att {
typedef float f32x16 __attribute__((ext_vector_type(16)));
typedef short s16x4 __attribute__((ext_vector_type(4)));
#define SBAR() __builtin_amdgcn_sched_barrier(0)
__device__ __forceinline__ int crow(int r, int hi) { return (r & 3) + 8 * (r >> 2) + 4 * hi; }
__device__ __forceinline__ unsigned cvtpk(float lo, float hi) { unsigned r; asm volatile("v_cvt_pk_bf16_f32 %0, %1, %2" : "=v"(r) : "v"(lo), "v"(hi)); return r; }
template <int ROWB> __device__ __forceinline__ int kswz(int row, int colB) { return row * ROWB + (colB ^ (((row >> 1) & 7) << 4)); }
__device__ __forceinline__ void partialSM(f32x16& p0, f32x16& p1, float& m_reg, float& mn, float& alpha, float C, float thr) {
  float pmax = p0[0];
#pragma unroll
  for (int r = 1; r < 16; ++r) pmax = fmaxf(pmax, p0[r]);
#pragma unroll
  for (int r = 0; r < 16; ++r) pmax = fmaxf(pmax, p1[r]);
  { auto rr = __builtin_amdgcn_permlane32_swap(__float_as_uint(pmax), __float_as_uint(pmax), false, false); pmax = fmaxf(__uint_as_float(rr[0]), __uint_as_float(rr[1])); }
  if (__builtin_expect(__all(pmax - m_reg <= thr), 1)) { mn = m_reg; alpha = 1.f; }
  else { mn = fmaxf(m_reg, pmax); alpha = __builtin_amdgcn_exp2f((m_reg - mn) * C); m_reg = mn; }
  const float mnC = -mn * C;
#pragma unroll
  for (int r = 0; r < 16; ++r) p0[r] = fmaf(p0[r], C, mnC);
#pragma unroll
  for (int r = 0; r < 16; ++r) p1[r] = fmaf(p1[r], C, mnC);
#pragma unroll
  for (int r = 0; r < 16; ++r) p0[r] = __builtin_amdgcn_exp2f(p0[r]);
}
__device__ __forceinline__ void finishSM(f32x16& p0, f32x16& p1, float alpha, float& l_reg, bf16x8& pa0, bf16x8& pa1, bf16x8& pa2, bf16x8& pa3) {
#pragma unroll
  for (int r = 0; r < 16; ++r) p1[r] = __builtin_amdgcn_exp2f(p1[r]);
  float ps = 0;
#pragma unroll
  for (int r = 0; r < 16; ++r) ps += p0[r];
#pragma unroll
  for (int r = 0; r < 16; ++r) ps += p1[r];
  { auto rr = __builtin_amdgcn_permlane32_swap(__float_as_uint(ps), __float_as_uint(ps), false, false); ps = __uint_as_float(rr[0]) + __uint_as_float(rr[1]); }
  l_reg = l_reg * alpha + ps;
#define PK4(P, BASE, OUT) do { unsigned a0 = cvtpk(P[BASE + 0], P[BASE + 1]), a1 = cvtpk(P[BASE + 2], P[BASE + 3]);   \
    unsigned b0 = cvtpk(P[BASE + 4], P[BASE + 5]), b1 = cvtpk(P[BASE + 6], P[BASE + 7]);                              \
    auto r0 = __builtin_amdgcn_permlane32_swap(a0, b0, false, false); auto r1 = __builtin_amdgcn_permlane32_swap(a1, b1, false, false); \
    v4u w = {r0[0], r1[0], r0[1], r1[1]}; OUT = __builtin_bit_cast(bf16x8, w); } while (0)
  PK4(p0, 0, pa0); PK4(p0, 8, pa1); PK4(p1, 0, pa2); PK4(p1, 8, pa3);
#undef PK4
}
template <int DQK> __device__ __forceinline__ void qkt(f32x16& p0, f32x16& p1, const LAS char* Ks, const bf16x8 (&qr)[DQK / 16], int r32, int hi) {
  p0 = f32x16{}; p1 = f32x16{};
  const int f = ((r32 >> 1) & 7) << 4; const LAS char* kb[4];
#pragma unroll
  for (int k = 0; k < 4; ++k) kb[k] = Ks + r32 * (DQK * 2) + ((k * 32 + hi * 16) ^ f);
#pragma unroll
  for (int d0 = 0; d0 < DQK / 16; ++d0) {
    const bf16x8 b0 = *(const LAS bf16x8*)(kb[d0 & 3] + (d0 >> 2) * 128);
    const bf16x8 b1 = *(const LAS bf16x8*)(kb[d0 & 3] + (d0 >> 2) * 128 + 32 * DQK * 2);
    p0 = __builtin_amdgcn_mfma_f32_32x32x16_bf16(b0, qr[d0], p0, 0, 0, 0);
    p1 = __builtin_amdgcn_mfma_f32_32x32x16_bf16(b1, qr[d0], p1, 0, 0, 0); }
}
__device__ __forceinline__ int v_st(int k, int c) { const int kk = (k & ~0xC) | ((k & 4) << 1) | ((k & 8) >> 1); return ((kk >> 3) * 4 + (c >> 5)) * 512 + ((kk & 7) * 32 + (c & 31)) * 2; }
__device__ __forceinline__ int v_rd_base(int lane) { return ((lane & 3) << 3) | (((lane >> 2) & 3) << 6) | (((lane >> 4) & 1) << 5) | (((lane >> 5) & 1) << 8); }
constexpr int v_rd_off(int d0, int ks, int half) { return d0 * 512 + ks * 4096 + half * 2048; }
template <int OFF> __device__ __forceinline__ s16x4 tr_read(int vb) { s16x4 r; asm volatile("ds_read_b64_tr_b16 %0, %1 offset:%2" : "=&v"(r) : "v"(vb), "i"(OFF) : "memory"); return r; }
template <int D0> __device__ __forceinline__ void pv_one(f32x16& od, int vb, bf16x8 pa0, bf16x8 pa1, bf16x8 pa2, bf16x8 pa3) {
  const s16x4 l0 = tr_read<v_rd_off(D0, 0, 0)>(vb), h0 = tr_read<v_rd_off(D0, 0, 1)>(vb), l1 = tr_read<v_rd_off(D0, 1, 0)>(vb), h1 = tr_read<v_rd_off(D0, 1, 1)>(vb);
  const s16x4 l2 = tr_read<v_rd_off(D0, 2, 0)>(vb), h2 = tr_read<v_rd_off(D0, 2, 1)>(vb), l3 = tr_read<v_rd_off(D0, 3, 0)>(vb), h3 = tr_read<v_rd_off(D0, 3, 1)>(vb);
  asm volatile("s_waitcnt lgkmcnt(0)" ::: "memory"); SBAR();
#define PK(L, H) (bf16x8){L[0], L[1], L[2], L[3], H[0], H[1], H[2], H[3]}
  od = __builtin_amdgcn_mfma_f32_32x32x16_bf16(pa0, PK(l0, h0), od, 0, 0, 0);
  od = __builtin_amdgcn_mfma_f32_32x32x16_bf16(pa1, PK(l1, h1), od, 0, 0, 0);
  od = __builtin_amdgcn_mfma_f32_32x32x16_bf16(pa2, PK(l2, h2), od, 0, 0, 0);
  od = __builtin_amdgcn_mfma_f32_32x32x16_bf16(pa3, PK(l3, h3), od, 0, 0, 0);
#undef PK
}
__device__ __forceinline__ void pv_d0(f32x16* o, int vb, bf16x8 pa0, bf16x8 pa1, bf16x8 pa2, bf16x8 pa3) {
  pv_one<0>(o[0], vb, pa0, pa1, pa2, pa3); pv_one<1>(o[1], vb, pa0, pa1, pa2, pa3); pv_one<2>(o[2], vb, pa0, pa1, pa2, pa3); pv_one<3>(o[3], vb, pa0, pa1, pa2, pa3);
}
template <int DQK, int NP1, int SDEPTH>
__device__ __forceinline__ void attn_unit(const bf16* __restrict__ Qb, int ldq, const bf16* __restrict__ Kb, int ldk, int kc1, int kc2, const bf16* __restrict__ Vh, int ldv,
                                          bf16* __restrict__ Ob, int ldo, int nkeys, float C, float thr, bool rope, int n0, const f32x2* __restrict__ rt, LAS char* lds, int tid) {
  constexpr int ND = DQK / 16, NPK = DQK / 8, KP = NPK / 8, SHM_V = 64 * 128 * 2, SHM_K = 64 * DQK * 2, ROWB = DQK * 2;
  const int wid = tid >> 6, lane = tid & 63, r32 = lane & 31, hi = lane >> 5;
  LAS char* V_lds = lds; LAS char* K_lds = lds + 2 * SHM_V;
  LAS float* ws = (LAS float*)(lds + 2 * SHM_V + 2 * SHM_K) + wid * 64; LAS float* li_l = ws; LAS float* al_l = ws + 32;
  float m_reg = -1e30f, l_reg = 0; f32x16 o[4] = {}; bf16x8 qr[ND];
  const bf16* Qw = Qb + (size_t)(wid * 32 + r32) * ldq + hi * 8;
#pragma unroll
  for (int d0 = 0; d0 < ND; ++d0) qr[d0] = *(const GAS bf16x8*)(Qw + d0 * 16);
  if (rope) { const int n = n0 + wid * 32 + r32, prow = n / GRIDW, pcol = n % GRIDW;
#pragma unroll
    for (int part = 0; part < 2; ++part) { const int pos = part ? pcol : prow; bf16x8& a = qr[ND - 4 + 2 * part]; bf16x8& b = qr[ND - 3 + 2 * part];
#pragma unroll
      for (int jj = 0; jj < 8; ++jj) { const f32x2 cs = rt[pos * 16 + hi * 8 + jj]; const float x1 = bflo((unsigned short)a[jj]), x2 = bflo((unsigned short)b[jj]);
        a[jj] = (short)f2bf(x1 * cs.x - x2 * cs.y); b[jj] = (short)f2bf(x2 * cs.x + x1 * cs.y); } } }
  const int sr = tid >> 4, sc = (tid & 15) * 8, vst0 = v_st(sr, sc), vst1 = v_st(32 + sr, sc);
  const int vb0 = (int)(uintptr_t)V_lds + v_rd_base(lane);
  int kgo[KP], klo[KP];
#pragma unroll
  for (int i = 0; i < KP; ++i) { const int idx = tid + 512 * i, row = idx / NPK, pc = idx % NPK; kgo[i] = row * ldk + (pc < NP1 ? kc1 + pc * 8 : kc2 + (pc - NP1) * 8); klo[i] = kswz<ROWB>(row, pc * 16); }
  struct { bf16x8 vs0, vs1, ks[KP]; } sr_[SDEPTH];
#define SLOAD(i, k0) do { sr_[i].vs0 = *(const GAS bf16x8*)(Vh + (size_t)((k0) + sr) * ldv + sc); sr_[i].vs1 = *(const GAS bf16x8*)(Vh + (size_t)((k0) + 32 + sr) * ldv + sc); \
    _Pragma("unroll") for (int _q = 0; _q < KP; ++_q) sr_[i].ks[_q] = *(const GAS bf16x8*)(Kb + (size_t)(k0) * ldk + kgo[_q]); } while (0)
#define SWRITE(b, i) do { *(LAS bf16x8*)(V_lds + (b) * SHM_V + vst0) = sr_[i].vs0; *(LAS bf16x8*)(V_lds + (b) * SHM_V + vst1) = sr_[i].vs1; \
    _Pragma("unroll") for (int _q = 0; _q < KP; ++_q) *(LAS bf16x8*)(K_lds + (b) * SHM_K + klo[_q]) = sr_[i].ks[_q]; } while (0)
#define SWAIT() do { if constexpr (SDEPTH == 2) { if constexpr (KP == 1) asm volatile("s_waitcnt vmcnt(3)" ::: "memory"); else asm volatile("s_waitcnt vmcnt(5)" ::: "memory"); } else asm volatile("s_waitcnt vmcnt(0)" ::: "memory"); } while (0)
#define RESC(a) do { if (__any((a) < 1.f)) { if (hi == 0) al_l[r32] = (a); asm volatile("s_waitcnt lgkmcnt(0)" ::: "memory"); \
    _Pragma("unroll") for (int d = 0; d < 4; ++d) _Pragma("unroll") for (int r = 0; r < 16; ++r) o[d][r] *= al_l[crow(r, hi)]; } } while (0)
  f32x16 pA0, pA1, pB0, pB1; float mnA, mnB, alA, alB; bf16x8 pa0, pa1, pa2, pa3; const int NT = nkeys / 64;
  constexpr int SE = 0, SO = SDEPTH - 1;
  SLOAD(SE, 0); asm volatile("s_waitcnt vmcnt(0)" ::: "memory"); SWRITE(0, SE); __syncthreads();
  qkt<DQK>(pA0, pA1, K_lds, qr, r32, hi); partialSM(pA0, pA1, m_reg, mnA, alA, C, thr);
  SLOAD(SO, 64); if constexpr (SDEPTH == 2) { if (2 < NT) SLOAD(SE, 128); }
  SWAIT(); SWRITE(1, SO); __syncthreads();
  for (int j = 1; j + 1 < NT; j += 2) {
    SBAR(); qkt<DQK>(pB0, pB1, K_lds + SHM_K, qr, r32, hi);
    finishSM(pA0, pA1, alA, l_reg, pa0, pa1, pa2, pa3); SBAR();
    SLOAD(SO, (j + SDEPTH) * 64); SBAR();
    pv_d0(o, vb0, pa0, pa1, pa2, pa3); partialSM(pB0, pB1, m_reg, mnB, alB, C, thr);
    __syncthreads(); SWAIT(); SWRITE(0, SE);
    RESC(alB); __syncthreads();
    SBAR(); qkt<DQK>(pA0, pA1, K_lds, qr, r32, hi);
    finishSM(pB0, pB1, alB, l_reg, pa0, pa1, pa2, pa3); SBAR();
    if (SDEPTH == 1 || j + 3 < NT) SLOAD(SE, (j + 1 + SDEPTH) * 64); SBAR();
    pv_d0(o, vb0 + SHM_V, pa0, pa1, pa2, pa3); partialSM(pA0, pA1, m_reg, mnA, alA, C, thr);
    __syncthreads(); SWAIT(); SWRITE(1, SO);
    RESC(alA); __syncthreads();
  }
  SBAR(); qkt<DQK>(pB0, pB1, K_lds + SHM_K, qr, r32, hi);
  finishSM(pA0, pA1, alA, l_reg, pa0, pa1, pa2, pa3); SBAR();
  pv_d0(o, vb0, pa0, pa1, pa2, pa3); partialSM(pB0, pB1, m_reg, mnB, alB, C, thr);
  __syncthreads(); RESC(alB);
  finishSM(pB0, pB1, alB, l_reg, pa0, pa1, pa2, pa3); SBAR();
  pv_d0(o, vb0 + SHM_V, pa0, pa1, pa2, pa3);
  if (hi == 0) li_l[r32] = l_reg; asm volatile("s_waitcnt lgkmcnt(0)" ::: "memory");
  bf16* Ow = Ob + (size_t)(wid * 32) * ldo; asm volatile("" : "+v"(Ow));
#pragma unroll
  for (int r = 0; r < 16; ++r) { const int orow = crow(r, hi); const float rl = __builtin_amdgcn_rcpf(li_l[orow]);
#pragma unroll
    for (int d0 = 0; d0 < 4; ++d0) Ow[(size_t)orow * ldo + d0 * 32 + r32] = (bf16)f2bf(o[d0][r] * rl); }
  __syncthreads();
#undef SLOAD
#undef SWRITE
#undef SWAIT
#undef RESC
}
template <int DQK, int NP1>
__device__ __forceinline__ void attn_unit_simple(const bf16* __restrict__ Qb, int ldq, const bf16* __restrict__ Kb, int ldk, int kc1, int kc2, const bf16* __restrict__ Vh, int ldv,
                                                 bf16* __restrict__ Ob, int ldo, int nkeys, float C, float thr, bool rope, int n0, const f32x2* __restrict__ rt, LAS char* lds, int tid) {
  constexpr int ND = DQK / 16, NPK = DQK / 8, KP = NPK / 8, SHM_V = 64 * 128 * 2, SHM_K = 64 * DQK * 2, ROWB = DQK * 2;
  const int wid = __builtin_amdgcn_readfirstlane(tid >> 6), lane = tid & 63, r32 = lane & 31, hi = lane >> 5;
  LAS char* V_lds = lds; LAS char* K_lds = lds + 2 * SHM_V;
  LAS float* ws = (LAS float*)(lds + 2 * SHM_V + 2 * SHM_K) + wid * 64; LAS float* li_l = ws; LAS float* al_l = ws + 32;
  float m_reg = -1e30f, l_reg = 0; f32x16 o[4] = {}; bf16x8 qr[ND];
  const bf16* Qw = Qb + (size_t)(wid * 32 + r32) * ldq + hi * 8;
#pragma unroll
  for (int d0 = 0; d0 < ND; ++d0) qr[d0] = *(const GAS bf16x8*)(Qw + d0 * 16);
  if (rope) { const int n = n0 + wid * 32 + r32, prow = n / GRIDW, pcol = n % GRIDW;
#pragma unroll
    for (int part = 0; part < 2; ++part) { const int pos = part ? pcol : prow; bf16x8& a = qr[ND - 4 + 2 * part]; bf16x8& b = qr[ND - 3 + 2 * part];
#pragma unroll
      for (int jj = 0; jj < 8; ++jj) { const f32x2 cs = rt[pos * 16 + hi * 8 + jj]; const float x1 = bflo((unsigned short)a[jj]), x2 = bflo((unsigned short)b[jj]);
        a[jj] = (short)f2bf(x1 * cs.x - x2 * cs.y); b[jj] = (short)f2bf(x2 * cs.x + x1 * cs.y); } } }
  const int vb0 = (int)(uintptr_t)V_lds + v_rd_base(lane);
  int kgo[KP], vgo[2];
#pragma unroll
  for (int t = 0; t < KP; ++t) { const int x = (wid + 8 * t) * 1024 + lane * 16, row = x / ROWB, pc = ((x % ROWB) >> 4) ^ ((row >> 1) & 7);
    kgo[t] = row * ldk + (pc < NP1 ? kc1 + pc * 8 : kc2 + (pc - NP1) * 8); }
#pragma unroll
  for (int t = 0; t < 2; ++t) { const int x = (wid + 8 * t) * 1024 + lane * 16, sub = x >> 9, y = x & 511, kk = (sub >> 2) * 8 + (y >> 6), c = (sub & 3) * 32 + ((y & 63) >> 1);
    const int k = (kk & ~0xC) | ((kk & 4) << 1) | ((kk & 8) >> 1); vgo[t] = k * ldv + c; }
#define STAGE(b, k0) do { const bf16* _kb = Kb + (size_t)(k0) * ldk; const bf16* _vb = Vh + (size_t)(k0) * ldv; \
    _Pragma("unroll") for (int _t = 0; _t < 2; ++_t) __builtin_amdgcn_global_load_lds((const GAS unsigned*)(_vb + vgo[_t]), (LAS unsigned*)(V_lds + (b) * SHM_V + (wid + 8 * _t) * 1024), 16, 0, 0); \
    _Pragma("unroll") for (int _t = 0; _t < KP; ++_t) __builtin_amdgcn_global_load_lds((const GAS unsigned*)(_kb + kgo[_t]), (LAS unsigned*)(K_lds + (b) * SHM_K + (wid + 8 * _t) * 1024), 16, 0, 0); } while (0)
  const int NT = nkeys / 64;
  STAGE(0, 0); asm volatile("s_waitcnt vmcnt(0)" ::: "memory"); __syncthreads();
  for (int j = 0; j < NT; ++j) {
    const int buf = j & 1; f32x16 p0, p1; float mn, al; bf16x8 pa0, pa1, pa2, pa3;
    if (j + 1 < NT) STAGE(buf ^ 1, (j + 1) * 64);
    qkt<DQK>(p0, p1, K_lds + buf * SHM_K, qr, r32, hi);
    partialSM(p0, p1, m_reg, mn, al, C, thr);
    finishSM(p0, p1, al, l_reg, pa0, pa1, pa2, pa3);
    if (__any(al < 1.f)) { if (hi == 0) al_l[r32] = al; asm volatile("s_waitcnt lgkmcnt(0)" ::: "memory");
#pragma unroll
      for (int d = 0; d < 4; ++d)
#pragma unroll
        for (int r = 0; r < 16; ++r) o[d][r] *= al_l[crow(r, hi)]; }
    SBAR();
    pv_d0(o, vb0 + buf * SHM_V, pa0, pa1, pa2, pa3);
    asm volatile("s_waitcnt vmcnt(0)" ::: "memory"); __syncthreads();
  }
  if (hi == 0) li_l[r32] = l_reg; asm volatile("s_waitcnt lgkmcnt(0)" ::: "memory");
  bf16* Ow = Ob + (size_t)(wid * 32) * ldo; asm volatile("" : "+v"(Ow));
#pragma unroll
  for (int r = 0; r < 16; ++r) { const int orow = crow(r, hi); const float rl = __builtin_amdgcn_rcpf(li_l[orow]);
#pragma unroll
    for (int d0 = 0; d0 < 4; ++d0) Ow[(size_t)orow * ldo + d0 * 32 + r32] = (bf16)f2bf(o[d0][r] * rl); }
  __syncthreads();
#undef STAGE
}
#undef SBAR
}
__device__ __forceinline__ void phase_attn(Frame& F, CArgs A) {
    WSL;
    const bf16* P = WSP(bf16, WS_P); const bf16* QK = WSP(bf16, WS_QKVB); const f32x2* rt = WSP(f32x2, WS_ROPE); LAS char* lds = (LAS char*)(F.lds + RING_OFF);
    constexpr float L2E = 1.4426950408889634f; constexpr size_t QLD = 1856;
    for (int L = lnd_i(F.vcu); L < 792; L += F.G) {
        const bool isctx = L >= 768; int u = isctx ? L - 768 : L; bool mla; int b, h, qblk;
        if (isctx) { mla = u < 8; if (!mla) u -= 8; b = mla ? u / 4 : u / 8; h = mla ? u % 4 : u % 8; qblk = -1; }
        else { mla = u < 256; if (!mla) u -= 256; const int bh = u >> 5; qblk = u & 31; b = mla ? bh / 4 : bh / 8; h = mla ? bh % 4 : bh % 8; }
        const size_t rb = (size_t)b * TB, rq = rb + (isctx ? 0 : CTX + qblk * 256); const int nkeys = isctx ? CTX : TB, n0 = isctx ? 0 : qblk * 256;
#ifndef DIFF_SD
#define DIFF_SD 1
#endif
#ifndef ATT_VARIANT
#define ATT_VARIANT 3
#endif
        if ((ATT_VARIANT & 1) && mla) att::attn_unit_simple<192, 16>(QK + rq * QLD + h * 192, QLD, QK + rb * QLD, QLD, 768 + h * 256, 1792, QK + rb * QLD + 768 + h * 256 + 128, QLD,
                                            WSP(bf16, WS_OCAT) + rq * 1024 + 512 + h * 128, 1024, nkeys, B_SCALE * L2E, 8.f / B_SCALE, !isctx, n0, rt, lds, F.tid);
        if ((ATT_VARIANT & 2) && !mla) att::attn_unit_simple<64, 8>(P + rq * 2048 + h * 64, 2048, P + rb * 2048, 2048, 512 + h * 64, 0, P + rb * 2048 + 1024 + (h >> 1) * 128, 2048,
                                      WSP(bf16, WS_OA2) + rq * 1024 + h * 128, 1024, nkeys, A_SCALE * L2E, 8.f / A_SCALE, !isctx, n0, rt, lds, F.tid);
    }
}
namespace scn {
constexpr int TS = 136;
constexpr int TS2 = 72;
constexpr int O_QT = 0, O_KT = O_QT + 64 * TS * 2, O_QP = O_KT + 64 * TS * 2, O_KPT = O_QP + 64 * TS * 2, O_VT = O_KPT + 128 * TS2 * 2, O_STB = O_VT + 128 * TS2 * 2,
              O_DEC = O_STB + 128 * TS * 2, O_QTOT = O_DEC + 512, O_END = O_QTOT + 2048;
static_assert(O_END <= RING_BYTES, "scan LDS map");
constexpr int O_ATT = LDSCTL_OFF + LC_MISC;
__device__ __forceinline__ f32x4 mfma16(bf16x8 a, bf16x8 b, f32x4 c) { return __builtin_amdgcn_mfma_f32_16x16x32_bf16(a, b, c, 0, 0, 0); }
__device__ __forceinline__ size_t kv_index(int dir, int b, int h, int blk) { return (size_t)((dir * 2 + b) * 8 + h) * 33 + blk; }
}
#ifndef SKIP_S1
#define SKIP_S1 0
#endif
#ifndef SKIP_S3
#define SKIP_S3 0
#endif
__device__ __forceinline__ void phase_scan1(Frame& F, CArgs A, int l) {
    if (SKIP_S1) return;
    WSL; using namespace scn;
    LAS unsigned char* L = F.lds + RING_OFF;
    LAS bf16* QT = (LAS bf16*)(L + O_QT); LAS bf16* KT = (LAS bf16*)(L + O_KT); LAS bf16* QP = (LAS bf16*)(L + O_QP); LAS bf16* KPT = (LAS bf16*)(L + O_KPT); LAS bf16* VT = (LAS bf16*)(L + O_VT);
    LAS bf16* STB = (LAS bf16*)(L + O_STB); LAS float* dec = (LAS float*)(L + O_DEC); LAS float* qtot = (LAS float*)(L + O_QTOT); LAS bf16* ATT = (LAS bf16*)(F.lds + O_ATT);
    const int tid = F.tid, lane = F.lane, w = __builtin_amdgcn_readfirstlane(tid >> 6), l15 = lane & 15, l4 = lane >> 4;
    const int d = (w & 1) * 64 + lane, rq = w >> 1;
    const bf16* P = WSP(bf16, WS_P);
    for (int it = lnd_i(F.vcu); it < 2 * 8 * 33 * 2; it += F.G) {
        const int dir = it & 1, blk = (it >> 1) % 33, bh = (it >> 1) / 33, h = bh & 7, b = bh >> 3;
        const int rowbase = b * TB + blk * 256; const float lb = WSP(float, WS_LBL)[l * D + h * 128 + d];
        bf16* QPP = WSP(bf16, dir ? WS_SC_QB : WS_SC_QF); bf16* OLOC = WSP(bf16, WS_SC_OLOC) + (size_t)dir * R * D;
        f32x4 st[8];
#pragma unroll
        for (int tn = 0; tn < 8; ++tn) st[tn] = (f32x4){0.f, 0.f, 0.f, 0.f};
        float CT = 0.f;
        for (int c = 0; c < 4; ++c) {
            const bf16* Pcol = P + h * 128 + d;
            float pc[16]; float run = 0.f;
#pragma unroll
            for (int i = 0; i < 16; ++i) { const int t = 64 * c + 16 * rq + i, row = rowbase + (dir ? 255 - t : t);
                const float z = bflo(Pcol[(size_t)row * CP + (dir ? 2048 : 1024)]); const float f = lb + (1.f - lb) / (1.f + __expf(-z)); run += __logf(f); pc[i] = run; }
            qtot[rq * 128 + d] = run;
            __syncthreads();
            const float t0 = qtot[d], t1 = qtot[128 + d], t2 = qtot[256 + d], t3 = qtot[384 + d];
            const float off = (rq > 0 ? t0 : 0.f) + (rq > 1 ? t1 : 0.f) + (rq > 2 ? t2 : 0.f), cmid = t0 + t1, c63 = (t0 + t1) + (t2 + t3);
            unsigned kp[8], vp[8]; float prev = 0.f;
#pragma unroll
            for (int i = 0; i < 16; ++i) { const int t = 16 * rq + i, row = rowbase + (dir ? 255 - (64 * c + t) : 64 * c + t); const float cum = off + pc[i];
                const float qv = bflo(Pcol[(size_t)row * CP]), vv = bflo(Pcol[(size_t)row * CP + 3072]), kv = 1.f - __expf(pc[i] - prev); prev = pc[i];
                QT[t * TS + d] = (bf16)f2bf(qv * __expf(cum - cmid)); KT[t * TS + d] = (bf16)f2bf(kv * __expf(cmid - cum)); QP[t * TS + d] = (bf16)f2bf(qv * __expf(cum));
                const unsigned kpv = f2bf(kv * __expf(c63 - cum)), vvv = f2bf(vv);
                if (i & 1) { kp[i >> 1] |= kpv << 16; vp[i >> 1] |= vvv << 16; } else { kp[i >> 1] = kpv; vp[i >> 1] = vvv; }
                (QPP + h * 128 + d)[(size_t)row * D] = (bf16)f2bf(qv * __expf(cum + CT)); }
            *(LAS v4u*)(KPT + d * TS2 + 16 * rq) = (v4u){kp[0], kp[1], kp[2], kp[3]}; *(LAS v4u*)(KPT + d * TS2 + 16 * rq + 8) = (v4u){kp[4], kp[5], kp[6], kp[7]};
            *(LAS v4u*)(VT + d * TS2 + 16 * rq) = (v4u){vp[0], vp[1], vp[2], vp[3]}; *(LAS v4u*)(VT + d * TS2 + 16 * rq + 8) = (v4u){vp[4], vp[5], vp[6], vp[7]};
            if (rq == 0) dec[d] = __expf(c63);
            CT += c63;
            __syncthreads();
            const int tm = w >> 1;
#pragma unroll
            for (int q = 0; q < 2; ++q) { const int tn = 2 * (w & 1) + q; f32x4 a = {0.f, 0.f, 0.f, 0.f};
                if (tn <= tm) {
#pragma unroll
                    for (int ks = 0; ks < 4; ++ks) a = mfma16(*(const LAS bf16x8*)(QT + (16 * tm + l15) * TS + 32 * ks + 8 * l4), *(const LAS bf16x8*)(KT + (16 * tn + l15) * TS + 32 * ks + 8 * l4), a); }
#pragma unroll
                for (int r = 0; r < 4; ++r) { const int t = 16 * tm + 4 * l4 + r, s = 16 * tn + l15; ATT[t * TS2 + s] = (bf16)f2bf(s <= t ? a[r] : 0.f); } }
            f32x4 oa[4];
#pragma unroll
            for (int q = 0; q < 4; ++q) oa[q] = (f32x4){0.f, 0.f, 0.f, 0.f};
            if (c > 0) {
#pragma unroll
                for (int ks = 0; ks < 4; ++ks) { const bf16x8 af = *(const LAS bf16x8*)(QP + (16 * tm + l15) * TS + 32 * ks + 8 * l4);
#pragma unroll
                    for (int q = 0; q < 4; ++q) oa[q] = mfma16(af, *(const LAS bf16x8*)(STB + (16 * (4 * (w & 1) + q) + l15) * TS + 32 * ks + 8 * l4), oa[q]); } }
            __syncthreads();
#pragma unroll
            for (int ks = 0; ks < 2; ++ks) { const bf16x8 af = *(const LAS bf16x8*)(ATT + (16 * tm + l15) * TS2 + 32 * ks + 8 * l4);
#pragma unroll
                for (int q = 0; q < 4; ++q) oa[q] = mfma16(af, *(const LAS bf16x8*)(VT + (16 * (4 * (w & 1) + q) + l15) * TS2 + 32 * ks + 8 * l4), oa[q]); }
#pragma unroll
            for (int q = 0; q < 4; ++q)
#pragma unroll
                for (int r = 0; r < 4; ++r) { const int tu = 64 * c + 16 * tm + r, rowu = rowbase + (dir ? 255 - tu - 12 : tu);
                    (OLOC + (dir ? 12 - 4 * l4 : 4 * l4) * D + l15)[(size_t)rowu * D + h * 128 + 16 * (4 * (w & 1) + q)] = (bf16)f2bf(oa[q][r]); }
            bf16x8 va[2];
#pragma unroll
            for (int ks = 0; ks < 2; ++ks) va[ks] = *(const LAS bf16x8*)(VT + (16 * w + l15) * TS2 + 32 * ks + 8 * l4);
#pragma unroll
            for (int tn = 0; tn < 8; ++tn) { st[tn] = st[tn] * dec[16 * tn + l15];
#pragma unroll
                for (int ks = 0; ks < 2; ++ks) st[tn] = mfma16(va[ks], *(const LAS bf16x8*)(KPT + (16 * tn + l15) * TS2 + 32 * ks + 8 * l4), st[tn]);
                if (c < 3) {
#pragma unroll
                    for (int r = 0; r < 4; ++r) STB[(16 * w + 4 * l4 + r) * TS + 16 * tn + l15] = (bf16)f2bf(st[tn][r]); } }
            __syncthreads();
        }
        float* KV = WSP(float, WS_SC_KV) + kv_index(dir, b, h, blk) * 16384;
#pragma unroll
        for (int tn = 0; tn < 8; ++tn)
#pragma unroll
            for (int r = 0; r < 4; ++r) KV[(16 * w + 4 * l4 + r) * 128 + 16 * tn + l15] = st[tn][r];
        if (rq == 0) WSP(float, WS_SC_DEC)[kv_index(dir, b, h, blk) * 128 + d] = __expf(CT);
    }
}
__device__ __forceinline__ void phase_scan2(Frame& F, CArgs A) {
    WSL; using namespace scn;
    const int gt = F.vcu * NTHR + F.tid, NGT = F.G * NTHR;
    for (int i = gt; i < 32 * 16384; i += NGT) { const int ed = i & 16383, seq = i >> 14, dirr = seq >> 4, dd = ed & 127;
        float* kv = WSP(float, WS_SC_KV) + (size_t)seq * 33 * 16384 + ed; const float* dc = WSP(float, WS_SC_DEC) + (size_t)seq * 33 * 128 + dd;
        float S = 0.f;
        for (int st = 0; st < 33; ++st) { const int blk = dirr ? (st == 0 ? 0 : 33 - st) : st; const float kvv = kv[(size_t)blk * 16384], de = dc[blk * 128]; kv[(size_t)blk * 16384] = S; S = de * S + kvv; } }
}
__device__ __forceinline__ void phase_scan3(Frame& F, CArgs A, int j) {
    if (SKIP_S3) return;
    WSL; using namespace scn;
    LAS bf16* SB = (LAS bf16*)(F.lds + RING_OFF);
    const int tid = F.tid, lane = F.lane, w = __builtin_amdgcn_readfirstlane(tid >> 6), l15 = lane & 15, l4 = lane >> 4;
    const float* ng = A->in[I_HNG] + j * 128; const bf16* P = WSP(bf16, WS_P);
    for (int it = lnd_i(F.vcu); it < 2 * 8 * 33; it += F.G) {
        const int blk = it % 33, bh = it / 33, h = bh & 7, b = bh >> 3, rowbase = b * TB + blk * 256;
        __syncthreads();
#pragma unroll
        for (int dir = 0; dir < 2; ++dir) { const float* sin = WSP(float, WS_SC_KV) + kv_index(dir, b, h, blk) * 16384;
#pragma unroll 2
            for (int q = 0; q < 8; ++q) { const unsigned idx = (unsigned)(tid + 512 * q) * 4u, e = idx >> 7, dd = idx & 127u; const f32x4 v = *(const GAS f32x4*)(sin + idx);
                v2u pw; pw.x = pk2(v.x, v.y); pw.y = pk2(v.z, v.w); *(LAS v2u*)(SB + (dir * 128 + e) * TS + dd) = pw; } }
        __syncthreads();
        const bf16* OF = WSP(bf16, WS_SC_OLOC); const bf16* OB = OF + (size_t)R * D;
#pragma unroll 1
        for (int mt = 0; mt < 2; ++mt) {
            f32x4 acc[8];
#pragma unroll
            for (int tn = 0; tn < 8; ++tn) acc[tn] = (f32x4){0.f, 0.f, 0.f, 0.f};
#pragma unroll
            for (int dir = 0; dir < 2; ++dir) { const bf16* Q = WSP(bf16, dir ? WS_SC_QB : WS_SC_QF);
                const bf16* qrow = Q + (size_t)(rowbase + 32 * w + 16 * mt + l15) * D + h * 128 + 8 * l4; bf16x8 af[4];
#pragma unroll
                for (int ks = 0; ks < 4; ++ks) af[ks] = *(const GAS bf16x8*)(qrow + 32 * ks);
#pragma unroll
                for (int ks = 0; ks < 4; ++ks)
#pragma unroll
                    for (int tn = 0; tn < 8; ++tn) acc[tn] = mfma16(af[ks], *(const LAS bf16x8*)(SB + (dir * 128 + 16 * tn + l15) * TS + 32 * ks + 8 * l4), acc[tn]); }
#pragma unroll
            for (int r = 0; r < 4; ++r) { const size_t row = (size_t)(rowbase + 32 * w + 16 * mt + 4 * l4 + r); float o[8], ss = 0.f;
#pragma unroll
                for (int tn = 0; tn < 8; ++tn) { const size_t ix = row * D + h * 128 + 16 * tn + l15; o[tn] = acc[tn][r] + bflo(OF[ix]) + bflo(OB[ix]); ss += o[tn] * o[tn]; }
#pragma unroll
                for (int x = 1; x < 16; x <<= 1) ss += __builtin_bit_cast(float, __builtin_amdgcn_ds_bpermute((lane ^ x) << 2, __builtin_bit_cast(int, ss)));
                const float rs = rsqrtf(ss * (1.f / 128.f) + EPS);
#pragma unroll
                for (int tn = 0; tn < 8; ++tn) { const int e = 16 * tn + l15; const float gt = bflo(P[row * CP + 4096 + h * 128 + e]);
                    WSP(bf16, WS_OCAT)[row * D + h * 128 + e] = (bf16)f2bf(o[tn] * rs * ng[e] * (gt / (1.f + __expf(-gt)))); } }
        }
    }
}
#ifndef SKIP_NM
#define SKIP_NM 0
#endif
#ifndef SKIP_INPROJ
#define SKIP_INPROJ 0
#endif
#ifndef SKIP_POST
#define SKIP_POST 0
#endif
#ifndef SKIP_UPPROJ
#define SKIP_UPPROJ 0
#endif
#ifndef SKIP_ATTN
#define SKIP_ATTN 0
#endif
#ifndef SKIP_DIFFC
#define SKIP_DIFFC 0
#endif
#ifndef SKIP_OUTPROJ
#define SKIP_OUTPROJ 0
#endif
#ifndef SKIP_M1
#define SKIP_M1 0
#endif
#ifndef SKIP_M2
#define SKIP_M2 0
#endif
#ifndef SKIP_M3
#define SKIP_M3 0
#endif
#ifndef SKIP_M4
#define SKIP_M4 0
#endif
#ifndef SKIP_P0
#define SKIP_P0 0
#endif
constexpr int PH_PER_LAYER = 16, PH_FINAL = 1 + PH_PER_LAYER * DEPTH, PH_END = PH_FINAL + 1;
template <int l> __device__ __forceinline__ void layer_body(Frame& F, const XcdBarrier& bar, const int lo, const int hi, const int flags) {
#define IN(k) (lo <= (k) && (k) < hi)
#define SEAM(k) do { if (IN(k) && IN((k) + 1)) xcd_barrier(bar); } while (0)
#define A get_args()
        constexpr int pb = 1 + PH_PER_LAYER * l, j = l >> 1; constexpr bool last = (l == DEPTH - 1);
        if (IN(pb + 0) && !SKIP_NM) { phase_nm(F, A, l, (l == 0 && !(flags & 2)) ? 1 : ((flags & 2) ? 0 : 2)); } SEAM(pb + 0);
        if constexpr ((l & 1) == 0) {
            if (IN(pb + 1) && !SKIP_INPROJ) { WSL;
                pg8::Gemm g{WSP(bf16, WS_U), WSP(bf16, WS_WINAB) + (size_t)j * 2048 * 1024, R, 2048, 1024, 0}; pg8::StaticOrder S; S.init(R, 2048, lnd_i(F.G), lnd_i((int)blockIdx.x));
                pg8::EpiBf16<0> E{WSP(bf16, WS_P), 2048, nullptr, 0, 0, 1.f};
                pg8::gemm_phase<pg8::EpiBf16<0>, pg8::StaticOrder, pg8::ADense, true>(F.lds + RING_OFF, g, S, E, pg8::ADense{}); } SEAM(pb + 1);
            if (IN(pb + 2) && !SKIP_POST) { phase_ab_post(F, A, j); } SEAM(pb + 2);
            if (IN(pb + 3) && !SKIP_UPPROJ) { WSL;
                pg8::Gemm g{WSP(bf16, WS_CQKV), WSP(bf16, WS_WUP) + (size_t)j * 1792 * 384, R, 1792, 384, 0}; pg8::StaticOrder S; S.init(R, 1792, lnd_i(F.G), lnd_i((int)blockIdx.x));
                pg8::EpiBf16<0> E{WSP(bf16, WS_QKVB), 1856, nullptr, 0, 0, 1.f};
                pg8::gemm_phase<pg8::EpiBf16<0>, pg8::StaticOrder, pg8::ADense, true>(F.lds + RING_OFF, g, S, E, pg8::ADense{}); } SEAM(pb + 3);
            if (IN(pb + 4) && !SKIP_ATTN) { phase_attn(F, A); } SEAM(pb + 4);
            if (IN(pb + 5) && !SKIP_DIFFC) { phase_diff_combine(F, A, j, l); } SEAM(pb + 5);
            if (IN(pb + 6) && !SKIP_OUTPROJ) { WSL;
                pg8::Gemm g{WSP(bf16, WS_OCAT), WSP(bf16, WS_WOUTAB) + (size_t)j * 1024 * 1024, R, 1024, 1024, 0}; pg8::StaticOrder S; S.init(R, 1024, lnd_i(F.G), lnd_i((int)blockIdx.x));
                pg8::EpiResid E{WSP(float, WS_H), WSP(float, WS_MOD) + (size_t)l * 18 * D + 2 * D};
                pg8::gemm_phase<pg8::EpiResid, pg8::StaticOrder, pg8::ADense, true>(F.lds + RING_OFF, g, S, E, pg8::ADense{}); } SEAM(pb + 6);
        } else {
            if (IN(pb + 1) && !SKIP_INPROJ) { WSL;
                pg8::Gemm g{WSP(bf16, WS_U), WSP(bf16, WS_WINC) + (size_t)j * 5120 * 1024, R, 5120, 1024, 0}; pg8::StaticOrder S; S.init(R, 5120, lnd_i(F.G), lnd_i((int)blockIdx.x));
                pg8::EpiBf16<0> E{WSP(bf16, WS_P), 5120, nullptr, 0, 0, 1.f};
                pg8::gemm_phase<pg8::EpiBf16<0>, pg8::StaticOrder, pg8::ADense, true>(F.lds + RING_OFF, g, S, E, pg8::ADense{}); } SEAM(pb + 1);
            if (IN(pb + 2) && !SKIP_POST) { phase_scan1(F, A, l); } SEAM(pb + 2);
            if (IN(pb + 3) && !SKIP_UPPROJ) { WSL; phase_scan2(F, A); } SEAM(pb + 3);
            if (IN(pb + 4) && !SKIP_ATTN) { phase_scan3(F, A, j); } SEAM(pb + 4);
            if (IN(pb + 6) && !SKIP_OUTPROJ) { WSL;
                pg8::Gemm g{WSP(bf16, WS_OCAT), WSP(bf16, WS_WOUTC) + (size_t)j * 1024 * 1024, R, 1024, 1024, 0}; pg8::StaticOrder S; S.init(R, 1024, lnd_i(F.G), lnd_i((int)blockIdx.x));
                pg8::EpiResid E{WSP(float, WS_H), WSP(float, WS_MOD) + (size_t)l * 18 * D + 2 * D};
                pg8::gemm_phase<pg8::EpiResid, pg8::StaticOrder, pg8::ADense, true>(F.lds + RING_OFF, g, S, E, pg8::ADense{}); } SEAM(pb + 6);
        }
        if (IN(pb + 7) && !SKIP_M1) { phase_m1(F, A, l, last); } SEAM(pb + 7);
        if (IN(pb + 8) && !SKIP_M2) { phase_m2(F, A, last); } SEAM(pb + 8);
        if (IN(pb + 9) && !SKIP_M3) { WSL;
            const pg8::MoeOrder S = moe_order(F, 8);
            pg8::Gemm g{WSP(bf16, WS_U), WSP(bf16, WS_W1) + (size_t)l * NE * 2048 * 1024, 0, 2048, 1024, (size_t)2048 * 1024 * 2};
            pg8::EpiSwiglu E{WSP(bf16, WS_ACT), A->in[I_B1] + (size_t)l * NE * 2048};
            pg8::gemm_phase<pg8::EpiSwiglu, pg8::MoeOrder, pg8::AGather, true>(F.lds + RING_OFF, g, S, E, pg8::AGather{WSP(int, WS_ROWIDX)}); } SEAM(pb + 9);
        if (IN(pb + 10) && !SKIP_M4) { WSL;
            const pg8::MoeOrder S = moe_order(F, 4);
            pg8::Gemm g{WSP(bf16, WS_ACT), WSP(bf16, WS_W2) + (size_t)l * NE * 1024 * 1024, 0, 1024, 1024, (size_t)1024 * 1024 * 2};
            pg8::EpiBiasE E{WSP(bf16, WS_YB), A->in[I_B2] + (size_t)l * NE * 1024};
            pg8::gemm_phase<pg8::EpiBiasE, pg8::MoeOrder, pg8::ADense, true>(F.lds + RING_OFF, g, S, E, pg8::ADense{}); }
        if (IN(pb + 10) && IN(pb + 16)) xcd_barrier(bar);
#undef A
#undef IN
#undef SEAM
}
__global__ void __launch_bounds__(NTHR, 2) fwd(Args Aval) {
    extern __shared__ __attribute__((aligned(16))) unsigned char lds_raw[];
    Frame F; F.lds = (LAS unsigned char*)lds_raw; F.tid = threadIdx.x; F.lane = F.tid & 63; F.wave = __builtin_amdgcn_readfirstlane(F.tid >> 6);
    F.G = gridDim.x; { const int bx = blockIdx.x; F.vcu = (F.G % 8 == 0) ? (bx % 8) * (F.G / 8) + bx / 8 : bx; }
    F.gw = F.vcu * NWAVES + F.wave; F.NGW = F.G * NWAVES; F.ws = Aval.ws;
    for (int u = F.tid; u < (LDS_BYTES - LDSCTL_OFF) / 4; u += NTHR) ((LAS unsigned*)(F.lds + LDSCTL_OFF))[u] = 0u;
    __syncthreads();
    XcdBarrier bar = xcd_barrier_post((unsigned*)(F.ws + WS_CTL) + CW_BAR, (volatile LAS unsigned*)(F.lds + LDSCTL_OFF + LC_BAR));
    const int lo = Aval.ph_lo, hi = Aval.ph_hi, flags = Aval.flags;
#define A get_args()
#define IN(k) (lo <= (k) && (k) < hi)
#define SEAM(k) do { if (IN(k) && IN((k) + 1)) xcd_barrier(bar); } while (0)
    if (IN(0) && !SKIP_P0) { phase_p0(F, A); xcd_barrier(bar); phase_p0b(F, A); } SEAM(0);
    layer_body<0>(F, bar, lo, hi, flags); layer_body<1>(F, bar, lo, hi, flags); layer_body<2>(F, bar, lo, hi, flags); layer_body<3>(F, bar, lo, hi, flags);
    if (IN(PH_FINAL)) { phase_nm(F, A, DEPTH, 2 | 4 | 8); }
#undef A
#undef IN
#undef SEAM
}
}
extern "C" void kernel_launch(void* const* d_in, const int* in_sizes, int n_in, void* d_out, int out_size, void* d_ws, size_t ws_size, hipStream_t stream) {
    static int grid = 0;
    if (grid == 0) {
        if (n_in != 27 || out_size != cfg::BATCH * cfg::SEQ * cfg::D || ws_size < mk::WS_END) { fprintf(stderr, "kernel_launch: unexpected shapes (n_in %d, out %d, ws %zu < %zu)\n", n_in, out_size, ws_size, (size_t)mk::WS_END); grid = -1; return; }
        int dev = 0, cus = 0, per_cu = 0;
        if (hipGetDevice(&dev) != hipSuccess || hipDeviceGetAttribute(&cus, hipDeviceAttributeMultiprocessorCount, dev) != hipSuccess) { grid = -1; return; }
        if (hipFuncSetAttribute((const void*)mk::fwd, hipFuncAttributeMaxDynamicSharedMemorySize, mk::LDS_BYTES) != hipSuccess) { fprintf(stderr, "kernel_launch: hipFuncSetAttribute failed\n"); grid = -1; return; }
        if (hipOccupancyMaxActiveBlocksPerMultiprocessor(&per_cu, (const void*)mk::fwd, mk::NTHR, mk::LDS_BYTES) != hipSuccess || per_cu < 1) fprintf(stderr, "kernel_launch: occupancy query says %d\n", per_cu);
        (void)hipGetLastError();
        grid = cus > 256 ? 256 : cus;
    }
    if (grid < 0) return;
    (void)hipMemsetAsync((char*)d_ws + mk::WS_CTL, 0, mk::CTL_ZERO_BYTES, stream);
    mk::Args a{}; for (int i = 0; i < 27; ++i) a.in[i] = (const float*)d_in[i];
    a.out = (float*)d_out; a.ws = (unsigned char*)d_ws; a.ph_lo = 0; a.ph_hi = mk::PH_END; a.flags = 0; a.pad = 0;
    hipLaunchKernelGGL(mk::fwd, dim3(grid), dim3(mk::NTHR), mk::LDS_BYTES, stream, a);
}
```
